# Optimizing an MI355X kernel written in HIP

```python
import math
import jax, jax.numpy as jnp
from jax import lax
import numpy as np

D_MODEL = 1024
BATCH = 4
SEQ = 8192
DEPTH = 1

CHUNK = 64
QBLK = 128
A_QBLK = CHUNK
HEAD_DIM = 64
A_HEADS = 8
A_DIM = A_HEADS * HEAD_DIM
IDX_HEADS = 8
IDX_DIM = 64
TOPK_MAX = 256
B_HEADS = 8
B_DIM = B_HEADS * HEAD_DIM
C_HEADS = 4
C_HEAD_DIM = 128
C_DIM = C_HEADS * C_HEAD_DIM
N_MEM = 256
N_BRANCH = 3
D_FF = ((8 * D_MODEL // 3 + 255) // 256) * 256
REL_BUCKETS = 32
REL_MAX_DIST = 128
EPS = 1e-6
SPLIT_SIZES = (A_DIM, A_DIM, A_DIM, IDX_HEADS * IDX_DIM, IDX_DIM, IDX_HEADS,
               B_DIM, B_DIM, B_DIM, C_DIM, N_BRANCH * D_MODEL)
N_IN = sum(SPLIT_SIZES)

kernel_name = 'hybrid_dsa_stickbreak_memory_block'


def rmsnorm(x, g):
    xf = x.astype(jnp.float32)
    y = xf * lax.rsqrt(jnp.mean(xf * xf, axis=-1, keepdims=True) + EPS)
    return (y * g.astype(jnp.float32)).astype(x.dtype)


def rel_bucket(rel):
    nb = REL_BUCKETS // 2
    max_exact = nb // 2
    n = jnp.abs(rel)
    large = max_exact + (jnp.log(jnp.maximum(n, 1).astype(jnp.float32) / max_exact)
                         / math.log(REL_MAX_DIST / max_exact) * (nb - max_exact)).astype(jnp.int32)
    large = jnp.minimum(large, nb - 1)
    return jnp.where(rel > 0, nb, 0) + jnp.where(n < max_exact, n, large)


def dsa_attention(aq, ak, av, iq, ik, iw, rel_bias):
    bsz, seq = aq.shape[0], aq.shape[1]
    k_sel = min(TOPK_MAX, seq // 4)
    key_chunk = jnp.arange(seq) // CHUNK
    gather = jax.vmap(lambda t, j: t[j])

    def block(i):
        q0 = i * A_QBLK
        qpos = q0 + jnp.arange(A_QBLK)
        qchunk = qpos // CHUNK
        iq_b = lax.dynamic_slice_in_dim(iq, q0, A_QBLK, axis=1)
        iw_b = lax.dynamic_slice_in_dim(iw, q0, A_QBLK, axis=1).astype(jnp.float32)
        aq_b = lax.dynamic_slice_in_dim(aq, q0, A_QBLK, axis=1)
        s = jnp.einsum('bqhd,bkd->bqhk', iq_b, ik).astype(jnp.float32) * IDX_DIM ** -0.5
        score = jnp.einsum('bqh,bqhk->bqk', iw_b, jax.nn.relu(s))
        admissible = key_chunk[None, :] <= qchunk[:, None]
        score = jnp.where(admissible[None], score, -jnp.inf)
        _, idx = lax.top_k(score, k_sel)
        valid = (idx // CHUNK) <= qchunk[None, :, None]
        kg = gather(ak, idx)
        vg = gather(av, idx)
        logits = jnp.einsum('bqhd,bqkhd->bhqk', aq_b, kg).astype(jnp.float32) * HEAD_DIM ** -0.5
        bias = rel_bias[rel_bucket(idx - qpos[None, :, None])]
        logits = logits + jnp.transpose(bias, (0, 3, 1, 2)).astype(jnp.float32)
        logits = jnp.where(valid[:, None], logits, -jnp.inf)
        p = jax.nn.softmax(logits, axis=-1).astype(vg.dtype)
        return jnp.einsum('bhqk,bqkhd->bqhd', p, vg)

    out = lax.map(block, jnp.arange(seq // A_QBLK))
    return jnp.transpose(out, (1, 0, 2, 3, 4)).reshape(bsz, seq, A_DIM)


def stick_breaking_attention(bq, bk, bv):
    bsz, seq = bq.shape[0], bq.shape[1]
    kpos = jnp.arange(seq)

    def block(i):
        q0 = i * QBLK
        qpos = q0 + jnp.arange(QBLK)
        q_b = lax.dynamic_slice_in_dim(bq, q0, QBLK, axis=1)
        z = jnp.einsum('bqhd,bkhd->bhqk', q_b, bk).astype(jnp.float32) * HEAD_DIM ** -0.5
        causal = kpos[None, :] < qpos[:, None]
        log_beta = jax.nn.log_sigmoid(z)
        log_one_minus = jnp.where(causal, jax.nn.log_sigmoid(-z), 0.0)
        tail = lax.cumsum(log_one_minus, axis=log_one_minus.ndim - 1, reverse=True) - log_one_minus
        a = jnp.where(causal, jnp.exp(log_beta + tail), 0.0).astype(bv.dtype)
        return jnp.einsum('bhqk,bkhd->bqhd', a, bv)

    out = lax.map(block, jnp.arange(seq // QBLK))
    return jnp.transpose(out, (1, 0, 2, 3, 4)).reshape(bsz, seq, B_DIM)


def memory_attention(cq, mk, mv):
    bsz, seq = cq.shape[0], cq.shape[1]
    logits = jnp.einsum('bshd,bmhd->bhsm', cq, mk).astype(jnp.float32) * C_HEAD_DIM ** -0.5
    p = jax.nn.softmax(logits, axis=-1).astype(mv.dtype)
    return jnp.einsum('bhsm,bmhd->bshd', p, mv).reshape(bsz, seq, C_DIM)


def setup_inputs(seed: int = 0) -> dict:
    key = jax.random.key(seed)
    ks = jax.random.split(key, 20)
    f32 = jnp.float32

    def w(k, shape, fan_in):
        return jax.random.normal(k, shape, f32) * fan_in ** -0.5

    def gain(k, shape):
        return 1.0 + 0.02 * jax.random.normal(k, shape, f32)

    return {
        'x': jax.random.normal(ks[0], (BATCH, SEQ, D_MODEL), f32),
        'mem': jax.random.normal(ks[1], (BATCH, N_MEM, D_MODEL), f32),
        'rel_bias': 0.5 * jax.random.normal(ks[2], (REL_BUCKETS, A_HEADS), f32),
        'g_mix_pre': gain(ks[3], (DEPTH, D_MODEL)),
        'w_in': w(ks[4], (DEPTH, D_MODEL, N_IN), D_MODEL),
        'b_gate': 0.02 * jax.random.normal(ks[5], (DEPTH, N_BRANCH * D_MODEL), f32),
        'g_mem': gain(ks[6], (DEPTH, D_MODEL)),
        'w_mem_kv': w(ks[7], (DEPTH, D_MODEL, 2 * C_DIM), D_MODEL),
        'w_up_a': w(ks[8], (DEPTH, A_DIM, D_MODEL), A_DIM),
        'w_up_b': w(ks[9], (DEPTH, B_DIM, D_MODEL), B_DIM),
        'w_up_c': w(ks[10], (DEPTH, C_DIM, D_MODEL), C_DIM),
        'w_out': w(ks[11], (DEPTH, D_MODEL, D_MODEL), D_MODEL),
        'g_mix_post': gain(ks[12], (DEPTH, D_MODEL)),
        'g_ffn_pre': gain(ks[13], (DEPTH, D_MODEL)),
        'w_ffn_in': w(ks[14], (DEPTH, D_MODEL, 2 * D_FF), D_MODEL),
        'w_ffn_out': w(ks[15], (DEPTH, D_FF, D_MODEL), D_FF),
        'g_ffn_post': gain(ks[16], (DEPTH, D_MODEL)),
    }


def reference(x, mem, rel_bias, g_mix_pre, w_in, b_gate, g_mem, w_mem_kv, w_up_a, w_up_b,
              w_up_c, w_out, g_mix_post, g_ffn_pre, w_ffn_in, w_ffn_out, g_ffn_post):
    bsz, seq = x.shape[0], x.shape[1]
    split_points = [int(v) for v in np.cumsum(SPLIT_SIZES)[:-1]]
    for l in range(DEPTH):
        h = rmsnorm(x, g_mix_pre[l])
        proj = h @ w_in[l]
        aq, ak, av, iq, ik, iw, bq, bk, bv, cq, gate_logits = jnp.split(proj, split_points, axis=-1)
        aq = aq.reshape(bsz, seq, A_HEADS, HEAD_DIM)
        ak = ak.reshape(bsz, seq, A_HEADS, HEAD_DIM)
        av = av.reshape(bsz, seq, A_HEADS, HEAD_DIM)
        iq = iq.reshape(bsz, seq, IDX_HEADS, IDX_DIM)
        iw = iw * IDX_HEADS ** -0.5
        bq = bq.reshape(bsz, seq, B_HEADS, HEAD_DIM)
        bk = bk.reshape(bsz, seq, B_HEADS, HEAD_DIM)
        bv = bv.reshape(bsz, seq, B_HEADS, HEAD_DIM)
        cq = cq.reshape(bsz, seq, C_HEADS, C_HEAD_DIM)
        mkv = rmsnorm(mem, g_mem[l]) @ w_mem_kv[l]
        mk = mkv[..., :C_DIM].reshape(bsz, N_MEM, C_HEADS, C_HEAD_DIM)
        mv = mkv[..., C_DIM:].reshape(bsz, N_MEM, C_HEADS, C_HEAD_DIM)

        ya = dsa_attention(aq, ak, av, iq, ik, iw, rel_bias) @ w_up_a[l]
        yb = stick_breaking_attention(bq, bk, bv) @ w_up_b[l]
        yc = memory_attention(cq, mk, mv) @ w_up_c[l]
        gates = jax.nn.sigmoid((gate_logits + b_gate[l]).astype(jnp.float32)).astype(x.dtype)
        gates = gates.reshape(bsz, seq, N_BRANCH, D_MODEL)
        merged = gates[:, :, 0] * ya + gates[:, :, 1] * yb + gates[:, :, 2] * yc
        x = x + rmsnorm(merged @ w_out[l], g_mix_post[l])

        h = rmsnorm(x, g_ffn_pre[l])
        gu = h @ w_ffn_in[l]
        f = (jax.nn.silu(gu[..., :D_FF]) * gu[..., D_FF:]) @ w_ffn_out[l]
        x = x + rmsnorm(f, g_ffn_post[l])
    return x
```

```cpp
#include <hip/hip_runtime.h>
#include <cstdio>
#include <cstdint>
#include <cmath>
#define MK_N_LAUNCHES 1
namespace pg8 {
#define PG8_LAS __attribute__((address_space(3)))
typedef unsigned short bf16_t;
typedef short bf16x8 __attribute__((ext_vector_type(8)));
typedef float f32x4 __attribute__((ext_vector_type(4)));
typedef unsigned u32x4 __attribute__((ext_vector_type(4)));
constexpr int BM = 256, BK = 64, HALF = 128, HTB = HALF * BK * 2  , STAGE_BYTES = 8 * HTB, NXCD = 8, WGM = 8;

__host__ __device__ __forceinline__ int lds_byte(int r, int c) { const int st = (r >> 4) * 2 + (c >> 5), rr = r & 15, cc = c & 31, ob = rr * 64 + cc * 2; return st * 1024 + (ob ^ (((ob >> 9) & 1) << 5)); }
__host__ __device__ __forceinline__ void stage_rc(int b, int& R, int& C) { const int st = b / 1024, sb = b % 1024, swz = sb ^ (((sb >> 9) & 1) << 5); R = (st >> 1) * 16 + swz / 64; C = (st & 1) * 32 + (swz % 64) / 2; }
__host__ __device__ __forceinline__ int perm32(int rho) { const int n = rho >> 4, i = rho & 15; return 8 * (i >> 2) + 4 * n + (i & 3); }

struct Unit { int pm, pn; };
struct Gemm { const bf16_t* A; const bf16_t* Bt; int M, N, K; };

struct StaticOrder {
    int nM, nN, nwg, G, c;
    __host__ __device__ void init(int M, int N, int G_, int c_) { nM = M / BM; nN = N / BM; nwg = nM * nN; G = G_; c = c_; }
    __host__ __device__ bool next(int i, Unit& u) const {
        const long L = (long)i * G + c; if (L >= nwg) return false;
        int wgid = (int)L; { const int q = nwg / NXCD, r = nwg % NXCD, xcd = wgid % NXCD, off = wgid / NXCD; wgid = (xcd < r ? xcd * (q + 1) : r * (q + 1) + (xcd - r) * q) + off; }
        const int nig = WGM * nN, gid = wgid / nig, fm = gid * WGM, gsz = (nM - fm) < WGM ? (nM - fm) : WGM;
        u.pm = fm + ((wgid % nig) % gsz); u.pn = (wgid % nig) / gsz; return true;
    }
    __device__ __forceinline__ void a_ready(const Unit&) const {}
    __device__ __forceinline__ void done(const Unit&) const {}
};

typedef float f32x2_e __attribute__((ext_vector_type(2))); typedef __bf16 bf16x2_e __attribute__((ext_vector_type(2)));
__device__ __forceinline__ unsigned cvt_pk_bf16(float lo, float hi) { f32x2_e v = {lo, hi}; bf16x2_e b = __builtin_convertvector(v, bf16x2_e); return __builtin_bit_cast(unsigned, b); }
__device__ __forceinline__ u32x4 pack8(const f32x4 v0, const f32x4 v1) { u32x4 w; w.x = cvt_pk_bf16(v0[0], v0[1]); w.y = cvt_pk_bf16(v0[2], v0[3]); w.z = cvt_pk_bf16(v1[0], v1[1]); w.w = cvt_pk_bf16(v1[2], v1[3]); return w; }
__device__ __forceinline__ float bf_lo(unsigned w) { return __uint_as_float(w << 16); }
__device__ __forceinline__ float bf_hi(unsigned w) { return __uint_as_float(w & 0xffff0000u); }
__device__ __forceinline__ float sigmoidf_(float x) { return __builtin_amdgcn_rcpf(1.0f + __expf(-x)); }

struct EpiStore {
    static constexpr bool PERM = true, AFTER_DRAIN = false;
    bf16_t* O; int ldc;
    __device__ __forceinline__ bool keep(const Unit&) const { return false; }
    __device__ __forceinline__ void operator()(f32x4 (&acc)[2][2][4][2], const Unit& u, int wr, int wc, int fr, int fq) const {
        const int row0 = u.pm * BM + wr * 64 + fr; const int col0 = u.pn * BM + wc * 32 + 8 * fq;
#pragma unroll
        for (int ai = 0; ai < 2; ++ai)
#pragma unroll
            for (int m = 0; m < 4; ++m) { bf16_t* rowp = O + (size_t)(row0 + ai * HALF + m * 16) * ldc + col0;
#pragma unroll
                for (int bj = 0; bj < 2; ++bj) *(u32x4*)(rowp + bj * HALF) = pack8(acc[ai][bj][m][0], acc[ai][bj][m][1]); }
    }
};

struct EpiProj {
    static constexpr bool PERM = true, AFTER_DRAIN = false;
    bf16_t* buf; size_t blk_elems; bf16_t* ik; float* iw; bf16_t* mkv; const float* bgate; float sc_a, sc_i, sc_c, sc_w; unsigned* cmp;
    __device__ __forceinline__ bool keep(const Unit&) const { return false; }
    __device__ __forceinline__ void st16(bf16_t* p, const u32x4 v, int cat) const {
        if (!cmp) { *(u32x4*)p = v; return; }
        const u32x4 o = *(const u32x4*)p; int bad = 0;
        const unsigned a[4] = {v.x, v.y, v.z, v.w}, b[4] = {o.x, o.y, o.z, o.w};
        for (int i = 0; i < 4; ++i) { const float a0 = bf_lo(a[i]), a1 = bf_hi(a[i]), b0 = bf_lo(b[i]), b1 = bf_hi(b[i]);
            bad += !(fabsf(a0 - b0) <= 0.03f * fabsf(b0) + 0.03f); bad += !(fabsf(a1 - b1) <= 0.03f * fabsf(b1) + 0.03f); }
        if (bad) atomicAdd(cmp + cat, 1u);
    }
    __device__ __forceinline__ void operator()(f32x4 (&acc)[2][2][4][2], const Unit& u, int wr, int wc, int fr, int fq) const {
        const int col8 = wc * 32 + 8 * fq;
        if (u.pn < 28) {
            const int blk = u.pn >> 1, cbase = (u.pn & 1) * 256 + col8; const int row0 = u.pm * BM + wr * 64 + fr;
            bf16_t* dst = buf + (size_t)blk * blk_elems + cbase;
            if (blk >= 8) {
                f32x4 bv[2][2];
#pragma unroll
                for (int bj = 0; bj < 2; ++bj)
#pragma unroll
                    for (int n = 0; n < 2; ++n) bv[bj][n] = *(const f32x4*)(bgate + (blk - 8) * 512 + cbase + bj * HALF + 4 * n);
#pragma unroll
                for (int ai = 0; ai < 2; ++ai)
#pragma unroll
                    for (int m = 0; m < 4; ++m) { bf16_t* rowp = dst + (size_t)(row0 + ai * HALF + m * 16) * 512;
#pragma unroll
                        for (int bj = 0; bj < 2; ++bj) { f32x4 v0 = acc[ai][bj][m][0] + bv[bj][0], v1 = acc[ai][bj][m][1] + bv[bj][1];
#pragma unroll
                            for (int e = 0; e < 4; ++e) { v0[e] = sigmoidf_(v0[e]); v1[e] = sigmoidf_(v1[e]); }
                            st16(rowp + bj * HALF, pack8(v0, v1), blk); } }
            } else {
                const float sc = (blk == 0 || blk == 4) ? sc_a : (blk == 3 ? sc_i : (blk == 7 ? sc_c : 1.0f));
#pragma unroll
                for (int ai = 0; ai < 2; ++ai)
#pragma unroll
                    for (int m = 0; m < 4; ++m) { bf16_t* rowp = dst + (size_t)(row0 + ai * HALF + m * 16) * 512;
#pragma unroll
                        for (int bj = 0; bj < 2; ++bj) st16(rowp + bj * HALF, pack8(acc[ai][bj][m][0] * sc, acc[ai][bj][m][1] * sc), blk); }
            }
        } else if (u.pn == 28) {
            const int row0 = u.pm * BM + wr * 64 + fr;
#pragma unroll
            for (int ai = 0; ai < 2; ++ai)
#pragma unroll
                for (int m = 0; m < 4; ++m) { const size_t row = (size_t)(row0 + ai * HALF + m * 16);
                    if (col8 < 64) st16(ik + row * 64 + col8, pack8(acc[ai][0][m][0], acc[ai][0][m][1]), 14);
                    else if (col8 == 64 && !cmp) { *(f32x4*)(iw + row * 8) = acc[ai][0][m][0] * sc_w; *(f32x4*)(iw + row * 8 + 4) = acc[ai][0][m][1] * sc_w; } }
        } else {
            const int row0 = (u.pm - 128) * BM + wr * 64 + fr; const int col0 = (u.pn - 29) * BM + col8;
#pragma unroll
            for (int ai = 0; ai < 2; ++ai)
#pragma unroll
                for (int m = 0; m < 4; ++m) { bf16_t* rowp = mkv + (size_t)(row0 + ai * HALF + m * 16) * 1024 + col0;
#pragma unroll
                    for (int bj = 0; bj < 2; ++bj) st16(rowp + bj * HALF, pack8(acc[ai][bj][m][0], acc[ai][bj][m][1]), 15); }
        }
    }
};

struct EpiMerge {
    static constexpr bool PERM = true, AFTER_DRAIN = false;
    const bf16_t* buf; size_t blk_elems; bf16_t* O;
    __device__ __forceinline__ bool keep(const Unit& u) const { return (u.pn >> 2) < 2; }
    __device__ __forceinline__ void operator()(f32x4 (&acc)[2][2][4][2], const Unit& u, int wr, int wc, int fr, int fq) const {
        const int br = u.pn >> 2, ct = u.pn & 3, rt = u.pm & 127;
        const int row0 = rt * BM + wr * 64 + fr, cbase = ct * 256 + wc * 32 + 8 * fq;
        const bf16_t* ga = buf + (size_t)(8 + 2 * br + (cbase >> 9)) * blk_elems + (cbase & 511);
        const bf16_t* gb = ga + 2 * blk_elems;
#pragma unroll
        for (int ai = 0; ai < 2; ++ai)
#pragma unroll
            for (int m = 0; m < 4; ++m) { const size_t row = (size_t)(row0 + ai * HALF + m * 16);
#pragma unroll
                for (int bj = 0; bj < 2; ++bj) {
                    const u32x4 a = *(const u32x4*)(ga + row * 512 + bj * HALF);
                    float f[8] = {bf_lo(a.x), bf_hi(a.x), bf_lo(a.y), bf_hi(a.y), bf_lo(a.z), bf_hi(a.z), bf_lo(a.w), bf_hi(a.w)};
                    if (br < 2) { const u32x4 b = *(const u32x4*)(gb + row * 512 + bj * HALF);
                        const float d[8] = {bf_lo(b.x), bf_hi(b.x), bf_lo(b.y), bf_hi(b.y), bf_lo(b.z), bf_hi(b.z), bf_lo(b.w), bf_hi(b.w)};
#pragma unroll
                        for (int e = 0; e < 8; ++e) f[e] = f[e] * __builtin_amdgcn_rcpf(fmaxf(d[e], 1e-30f)); }
                    f32x4 v0 = acc[ai][bj][m][0], v1 = acc[ai][bj][m][1];
                    v0[0] *= f[0]; v0[1] *= f[1]; v0[2] *= f[2]; v0[3] *= f[3]; v1[0] *= f[4]; v1[1] *= f[5]; v1[2] *= f[6]; v1[3] *= f[7];
                    if (br < 2) { acc[ai][bj][m][0] = v0; acc[ai][bj][m][1] = v1; }
                    else *(u32x4*)(O + row * 1024 + cbase + bj * HALF) = pack8(v0, v1);
                } }
    }
};

struct EpiSwiGLU {
    static constexpr bool PERM = true, AFTER_DRAIN = false;
    bf16_t* O; int ldc;
    __device__ __forceinline__ bool keep(const Unit&) const { return false; }
    __device__ __forceinline__ void operator()(f32x4 (&acc)[2][2][4][2], const Unit& u, int wr, int wc, int fr, int fq) const {
        const int row0 = u.pm * BM + wr * 64 + fr; const int col0 = u.pn * HALF + wc * 32 + 8 * fq;
#pragma unroll
        for (int ai = 0; ai < 2; ++ai)
#pragma unroll
            for (int m = 0; m < 4; ++m) { f32x4 h0, h1;
#pragma unroll
                for (int e = 0; e < 4; ++e) { const float g0 = acc[ai][0][m][0][e], g1 = acc[ai][0][m][1][e];
                    h0[e] = g0 * sigmoidf_(g0) * acc[ai][1][m][0][e]; h1[e] = g1 * sigmoidf_(g1) * acc[ai][1][m][1][e]; }
                *(u32x4*)(O + (size_t)(row0 + ai * HALF + m * 16) * ldc + col0) = pack8(h0, h1); }
    }
};

template <class Epi, class Sched, bool ALIGN_EPI = false, bool SP2 = false>
__device__ __forceinline__ void gemm_phase(PG8_LAS unsigned char* lds, const Gemm g, const Sched& S, const Epi& E) {
    const int tid = threadIdx.x, wid = __builtin_amdgcn_readfirstlane(tid >> 6), lane = tid & 63, wr = wid >> 2, wc = wid & 3, fr = lane & 15, fq = lane >> 4;
    const int K = g.K, nt = K / BK;
    unsigned voffA[2], voffB[2];
#pragma unroll
    for (int i = 0; i < 2; ++i) { int R, C; stage_rc(tid * 16 + i * 8192, R, C); const int Rb = Epi::PERM ? ((R & ~31) + perm32(R & 31)) : R;
        voffA[i] = (unsigned)(R * K + C) * 2u; voffB[i] = (unsigned)(Rb * K + C) * 2u; }
    const size_t kstep = (size_t)(BK * 2);
    const size_t hstep = (size_t)HALF * K * 2;
    const size_t tstep = 2 * hstep;
    const unsigned ldsw = (unsigned)wid * 1024u;
    const int aoff = lds_byte(wr * 64 + fr, fq * 8), boff = lds_byte(wc * 32 + fr, fq * 8);
#define PG8_SA(b, h) (((b) * 2 + (h)) * HTB)
#define PG8_SB(b, h) ((4 + (b) * 2 + (h)) * HTB)
#define PG8_STAGE(bufoff, gbase, voff) do { _Pragma("unroll") for (int _i = 0; _i < 2; ++_i) \
        __builtin_amdgcn_global_load_lds((const unsigned*)((const char*)(gbase) + (voff)[_i]), (PG8_LAS unsigned*)(lds + (bufoff) + ldsw + _i * 8192), 16, 0, 0); } while (0)
#define PG8_LDA(dst, b, h) do { _Pragma("unroll") for (int m = 0; m < 4; ++m) _Pragma("unroll") for (int k = 0; k < 2; ++k) dst[m][k] = *(const PG8_LAS bf16x8*)(lds + PG8_SA(b, h) + aoff + m * 2048 + k * 1024); } while (0)
#define PG8_LDB(dst, b, h) do { _Pragma("unroll") for (int n = 0; n < 2; ++n) _Pragma("unroll") for (int k = 0; k < 2; ++k) dst[n][k] = *(const PG8_LAS bf16x8*)(lds + PG8_SB(b, h) + boff + n * 2048 + k * 1024); } while (0)
#define PG8_MMA(ai, bj, At, Bt) do { __builtin_amdgcn_s_setprio(1); _Pragma("unroll") for (int m = 0; m < 4; ++m) _Pragma("unroll") for (int n = 0; n < 2; ++n) _Pragma("unroll") for (int k = 0; k < 2; ++k) \
        acc[ai][bj][m][n] = __builtin_amdgcn_mfma_f32_16x16x32_bf16(Bt[n][k], At[m][k], acc[ai][bj][m][n], 0, 0, 0); __builtin_amdgcn_s_setprio(0); } while (0)
#define PG8_WAIT_V(n) asm volatile("s_waitcnt vmcnt(" #n ")" ::: "memory")
#define PG8_WAIT_L(n) asm volatile("s_waitcnt lgkmcnt(" #n ")" ::: "memory")
#define PG8_BAR __builtin_amdgcn_s_barrier()
#define PG8_SCHED __builtin_amdgcn_sched_barrier(0)
    Unit cur, nxt; int ui = 0;
    if (!S.next(0, cur)) return;
    f32x4 acc[2][2][4][2];
#pragma unroll
    for (int a = 0; a < 2; ++a)
#pragma unroll
        for (int b = 0; b < 2; ++b)
#pragma unroll
            for (int m = 0; m < 4; ++m)
#pragma unroll
                for (int n = 0; n < 2; ++n) acc[a][b][m][n] = (f32x4){0.f, 0.f, 0.f, 0.f};
    bf16x8 At[4][2], B0[2][2], B1[2][2];
    const char* cA = (const char*)g.A + (size_t)cur.pm * tstep; const char* cB = (const char*)g.Bt + (size_t)cur.pn * tstep;
    S.a_ready(cur);
    if constexpr (SP2) {
        PG8_STAGE(PG8_SB(0, 0), cB, voffB); PG8_STAGE(PG8_SB(0, 1), cB + hstep, voffB); PG8_STAGE(PG8_SA(0, 0), cA, voffA); PG8_STAGE(PG8_SA(0, 1), cA + hstep, voffA);
        if (wr == 1) PG8_BAR;
        PG8_WAIT_V(2); PG8_BAR;
        PG8_STAGE(PG8_SB(1, 0), cB + kstep, voffB); PG8_STAGE(PG8_SA(1, 0), cA + kstep, voffA); PG8_STAGE(PG8_SB(1, 1), cB + hstep + kstep, voffB);
        PG8_WAIT_V(6); PG8_BAR;
    } else {
        PG8_STAGE(PG8_SB(0, 0), cB, voffB); PG8_STAGE(PG8_SA(0, 0), cA, voffA); PG8_STAGE(PG8_SB(0, 1), cB + hstep, voffB); PG8_STAGE(PG8_SA(0, 1), cA + hstep, voffA);
        if (wr == 1) PG8_BAR;
        PG8_WAIT_V(4); PG8_BAR;
        PG8_STAGE(PG8_SB(1, 0), cB + kstep, voffB); PG8_STAGE(PG8_SA(1, 0), cA + kstep, voffA); PG8_STAGE(PG8_SB(1, 1), cB + hstep + kstep, voffB);
        PG8_WAIT_V(6); PG8_BAR;
    }
    for (;;) {
        const bool has_next = S.next(ui + 1, nxt);
        const char* nA = has_next ? (const char*)g.A + (size_t)nxt.pm * tstep : cA; const char* nB = has_next ? (const char*)g.Bt + (size_t)nxt.pn * tstep : cB;
        for (int t = 0; t < nt; t += 2) {
            const bool last = (t == nt - 2);
            const char* a1 = cA + (size_t)(t + 1) * kstep;
            const char* a2 = last ? nA : cA + (size_t)(t + 2) * kstep; const char* b2 = last ? nB : cB + (size_t)(t + 2) * kstep;
            const char* a3 = a2 + kstep; const char* b3 = b2 + kstep;
            if (last && has_next) S.a_ready(nxt);
            if constexpr (SP2) {
            PG8_LDB(B0, 0, 0); PG8_LDB(B1, 0, 1); PG8_SCHED; PG8_LDA(At, 0, 0); PG8_STAGE(PG8_SA(1, 1), a1 + hstep, voffA);
            PG8_WAIT_V(8); PG8_WAIT_L(0); PG8_BAR; PG8_MMA(0, 0, At, B0); PG8_MMA(0, 1, At, B1); PG8_BAR; PG8_SCHED;
            PG8_LDA(At, 0, 1); PG8_STAGE(PG8_SB(0, 0), b2, voffB); PG8_STAGE(PG8_SB(0, 1), b2 + hstep, voffB); PG8_STAGE(PG8_SA(0, 0), a2, voffA);
            PG8_WAIT_V(8); PG8_WAIT_L(0); PG8_BAR; PG8_MMA(1, 0, At, B0); PG8_MMA(1, 1, At, B1); PG8_BAR; PG8_SCHED;
            PG8_LDB(B0, 1, 0); PG8_LDB(B1, 1, 1); PG8_SCHED; PG8_LDA(At, 1, 0); PG8_STAGE(PG8_SA(0, 1), a2 + hstep, voffA);
            PG8_WAIT_V(8); PG8_WAIT_L(0); PG8_BAR; PG8_MMA(0, 0, At, B0); PG8_MMA(0, 1, At, B1); PG8_BAR; PG8_SCHED;
            PG8_LDA(At, 1, 1); PG8_STAGE(PG8_SB(1, 0), b3, voffB); PG8_STAGE(PG8_SB(1, 1), b3 + hstep, voffB); PG8_STAGE(PG8_SA(1, 0), a3, voffA);
            PG8_WAIT_V(8); PG8_WAIT_L(0); PG8_BAR; PG8_MMA(1, 0, At, B0); PG8_MMA(1, 1, At, B1); PG8_BAR; PG8_SCHED;
            } else {
            PG8_LDB(B0, 0, 0); PG8_SCHED; PG8_LDA(At, 0, 0); PG8_STAGE(PG8_SA(1, 1), a1 + hstep, voffA);
            PG8_WAIT_L(8); PG8_BAR; PG8_WAIT_L(0); PG8_MMA(0, 0, At, B0); PG8_BAR; PG8_SCHED;
            PG8_LDB(B1, 0, 1); PG8_STAGE(PG8_SB(0, 0), b2, voffB);
            PG8_BAR; PG8_WAIT_L(0); PG8_MMA(0, 1, At, B1); PG8_BAR;
            PG8_LDA(At, 0, 1); PG8_STAGE(PG8_SA(0, 0), a2, voffA);
            PG8_BAR; PG8_WAIT_L(0); PG8_MMA(1, 0, At, B0); PG8_BAR; PG8_SCHED;
            PG8_STAGE(PG8_SB(0, 1), b2 + hstep, voffB);
            PG8_WAIT_V(6); PG8_BAR; PG8_MMA(1, 1, At, B1); PG8_BAR;
            PG8_LDB(B0, 1, 0); PG8_SCHED; PG8_LDA(At, 1, 0); PG8_STAGE(PG8_SA(0, 1), a2 + hstep, voffA);
            PG8_WAIT_L(8); PG8_BAR; PG8_WAIT_L(0); PG8_MMA(0, 0, At, B0); PG8_BAR; PG8_SCHED;
            PG8_LDB(B1, 1, 1); PG8_STAGE(PG8_SB(1, 0), b3, voffB);
            PG8_BAR; PG8_WAIT_L(0); PG8_MMA(0, 1, At, B1); PG8_BAR;
            PG8_LDA(At, 1, 1); PG8_STAGE(PG8_SA(1, 0), a3, voffA);
            PG8_BAR; PG8_WAIT_L(0); PG8_MMA(1, 0, At, B0); PG8_BAR; PG8_SCHED;
            PG8_STAGE(PG8_SB(1, 1), b3 + hstep, voffB);
            PG8_WAIT_V(6); PG8_BAR; PG8_MMA(1, 1, At, B1); PG8_BAR;
            }
        }
        if constexpr (ALIGN_EPI) { if (wr == 0) PG8_BAR; }
        if constexpr (!Epi::AFTER_DRAIN) { E(acc, cur, wr, wc, fr, fq); S.done(cur); }
        if (!has_next) break;
        if (!E.keep(cur))
#pragma unroll
        for (int a = 0; a < 2; ++a)
#pragma unroll
            for (int b = 0; b < 2; ++b)
#pragma unroll
                for (int m = 0; m < 4; ++m)
#pragma unroll
                    for (int n = 0; n < 2; ++n) acc[a][b][m][n] = (f32x4){0.f, 0.f, 0.f, 0.f};
        cur = nxt; cA = nA; cB = nB; ++ui;
        if constexpr (ALIGN_EPI) { if (wr == 1) PG8_BAR; }
    }
    PG8_WAIT_V(0);
    if constexpr (!ALIGN_EPI) { if (wr == 0) PG8_BAR; }
    PG8_BAR;
    if constexpr (Epi::AFTER_DRAIN) { E.fused(acc, cur, wr, wc, fr, fq, lds, wid, lane); S.done(cur); }
#undef PG8_SA
#undef PG8_SB
#undef PG8_STAGE
#undef PG8_LDA
#undef PG8_LDB
#undef PG8_MMA
#undef PG8_WAIT_V
#undef PG8_WAIT_L
#undef PG8_BAR
#undef PG8_SCHED
}
}

#ifndef PG8_SP2
#define PG8_SP2 true
#endif
#ifndef PG8_ALIGN
#define PG8_ALIGN true
#endif

constexpr int NWAVES = 8;
#ifndef MK_N_LAUNCHES
#define MK_N_LAUNCHES 1
#endif
constexpr int N_PHASES = 9;
constexpr int N_LAUNCHES = MK_N_LAUNCHES;

constexpr int BATCH = 4, SEQ = 8192, D = 1024, M = BATCH * SEQ;
constexpr int NMEM = 256, MROWS = BATCH * NMEM;
constexpr int NIN = 7240, DFF = 2816, NCHUNK = SEQ / 64;
constexpr float EPS = 1e-6f;
constexpr float LOG2E = 1.4426950408889634f;
constexpr int NIN_PAD = 7424;
constexpr size_t BLK = (size_t)M * 512;

constexpr size_t MiB = 1u << 20;
constexpr size_t WS_CTL = 0, CTL_ZERO_BYTES = 1 * MiB;
constexpr size_t WS_WIN = 2 * MiB;
constexpr size_t WS_WUP = 21 * MiB;
constexpr size_t WS_WOUT = 24 * MiB;
constexpr size_t WS_WFI = 26 * MiB;
constexpr size_t WS_WFO = 37 * MiB;
constexpr size_t WS_IK = 43 * MiB;
constexpr size_t WS_IW = 47 * MiB;
constexpr size_t WS_MKV = 48 * MiB;
constexpr size_t WS_BUF = 50 * MiB;
constexpr size_t WS_END = WS_BUF + 14 * BLK * 2;
static_assert(WS_WIN + (size_t)(NIN_PAD + 2048) * 1024 * 2 <= WS_WUP && WS_WFI + (size_t)2 * DFF * 1024 * 2 <= WS_WFO && WS_WFO + (size_t)1024 * DFF * 2 <= WS_IK && WS_END <= 512 * MiB, "d_ws map");
enum { B_AQ = 0, B_AK = 1, B_AV = 2, B_IQ = 3, B_BQ = 4, B_BK = 5, B_BV = 6, B_CQ = 7, B_G = 8 };
constexpr int CW_TMO = 0, CW_CODE = 1, CW_BAR = 4096;

constexpr int RING_OFF = 0, RING_BYTES = 131072;
constexpr int LDSCTL_OFF = RING_BYTES, MISC_OFF = LDSCTL_OFF + 320;
constexpr int LDS_BYTES = 147456;
static_assert(MISC_OFF + 128 <= LDS_BYTES, "LDS map");
constexpr int MASK_STRIDE = 258;
constexpr int L_MASK = 0, L_MASK_BYTES = 64 * MASK_STRIDE * 4;
constexpr int CAND_CAP = 32;
constexpr int L_CVAL = L_MASK + L_MASK_BYTES, L_CIDX = L_CVAL + 64 * CAND_CAP * 4, L_CCNT = L_CIDX + 64 * CAND_CAP * 4, L_THR = L_CCNT + 256, L_NEED = L_THR + 256;
constexpr int L_LUT = L_NEED + 256;
constexpr int L_VST = L_LUT + 8192;
constexpr int L_VST2 = 0;
static_assert(L_VST % 16 == 0 && L_VST + 8 * 4096 <= RING_BYTES, "P2 LDS map");

#define GAS __attribute__((address_space(1)))
#define LAS __attribute__((address_space(3)))
#define DI __device__ __forceinline__
typedef unsigned short bf16;
typedef unsigned v4u __attribute__((ext_vector_type(4)));
typedef unsigned v2u __attribute__((ext_vector_type(2)));
typedef float f32x4 __attribute__((ext_vector_type(4)));
typedef float f32x16 __attribute__((ext_vector_type(16)));
typedef short bf16x8 __attribute__((ext_vector_type(8)));
typedef short s16x4 __attribute__((ext_vector_type(4)));
typedef GAS unsigned gu32;
typedef GAS unsigned long long gu64;
#define RLX_AGENT __ATOMIC_RELAXED, __HIP_MEMORY_SCOPE_AGENT
#define LDS_WAIT() asm volatile("s_waitcnt lgkmcnt(0)" ::: "memory")
#define VM_WAIT() asm volatile("s_waitcnt vmcnt(0)" ::: "memory")
DI unsigned f2bf(float f) { unsigned u = __builtin_bit_cast(unsigned, f); return (u + 0x7fffu + ((u >> 16) & 1u)) >> 16; }
DI unsigned pk2(float lo, float hi) { return f2bf(lo) | (f2bf(hi) << 16); }
typedef float f32x2_t __attribute__((ext_vector_type(2))); typedef __bf16 bf16x2_t __attribute__((ext_vector_type(2)));
DI unsigned cvtpk(float lo, float hi) { f32x2_t v = {lo, hi}; bf16x2_t b = __builtin_convertvector(v, bf16x2_t); return __builtin_bit_cast(unsigned, b); }
DI f32x16 mfma32(bf16x8 a, bf16x8 b, f32x16 c) { return __builtin_amdgcn_mfma_f32_32x32x16_bf16(a, b, c, 0, 0, 0); }
DI f32x4 mfma16(bf16x8 a, bf16x8 b, f32x4 c) { return __builtin_amdgcn_mfma_f32_16x16x32_bf16(a, b, c, 0, 0, 0); }
typedef short v4i16_t __attribute__((ext_vector_type(4)));
DI s16x4 vtr(const LAS unsigned char* p) { return __builtin_bit_cast(s16x4, __builtin_amdgcn_ds_read_tr16_b64_v4i16((LAS v4i16_t*)p)); }
DI float ex2(float x) { return __builtin_amdgcn_exp2f(x); }
DI float lg2(float x) { return __builtin_amdgcn_logf(x); }
DI int crow(int r, int hi) { return (r & 3) + 8 * (r >> 2) + 4 * hi; }

#define XB_TMO      128
#define XB_XCNT(j)  (256  + 64 * (j))
#define XB_XSUB(j)  (1280 + 64 * (j))
#define XB_XGEN(j)  (2304 + 64 * (j))
#define XB_TOP      3328
#define XB_TOPGEN   3392
#define XCD_BAR_WORDS 3456
#define XB_SPIN_CAP (1u << 18)

__device__ __forceinline__ unsigned xb_ld(unsigned* p)              { return __hip_atomic_load(p, __ATOMIC_RELAXED, __HIP_MEMORY_SCOPE_AGENT); }
__device__ __forceinline__ unsigned xb_add(unsigned* p, unsigned v) { return __hip_atomic_fetch_add(p, v, __ATOMIC_RELAXED, __HIP_MEMORY_SCOPE_AGENT); }
__device__ __forceinline__ unsigned xb_xcc_id() { return (unsigned)__builtin_amdgcn_s_getreg((3 << 11) | 20) & 0xFu; }
#define XB_SPIN(cond, bar) do { unsigned _sp = 0; while (cond) { __builtin_amdgcn_s_sleep(1); \
    if ((++_sp & 255u) == 0u) { if (xb_ld(&(bar)[XB_TMO])) break; if (_sp > XB_SPIN_CAP) { atomicAdd(&(bar)[XB_TMO], 1u); break; } } } } while (0)

struct XcdBarrier {
    unsigned* bar; unsigned x;
    volatile LAS unsigned* st;
};

__device__ __forceinline__ XcdBarrier xcd_barrier_post(unsigned* bar, volatile LAS unsigned* st) {
    XcdBarrier b; b.bar = bar; b.x = xb_xcc_id(); b.st = st;
    if (threadIdx.x == 0) (void)xb_add(&bar[XB_XCNT(b.x)], 1u);
    return b;
}
__device__ __forceinline__ void xcd_barrier_complete(unsigned* bar, unsigned x, unsigned& nloc, unsigned& nx) {
    const unsigned G = gridDim.x * gridDim.y * gridDim.z;
    unsigned sum, cnt, mine, sp = 0u;
    for (;;) {
        sum = 0u; cnt = 0u; mine = 0u;
#pragma unroll
        for (unsigned j = 0; j < 16; ++j) { const unsigned c = xb_ld(&bar[XB_XCNT(j)]); sum += c; cnt += (c > 0u) ? 1u : 0u; mine = (j == x) ? c : mine; }
        if (sum == G) break;
        __builtin_amdgcn_s_sleep(1);
        if ((++sp & 255u) == 0u) { if (xb_ld(&bar[XB_TMO])) break; if (sp > XB_SPIN_CAP) { atomicAdd(&bar[XB_TMO], 1u); break; } }
    }
    nloc = mine > 0u ? mine : 1u; nx = cnt > 0u ? cnt : 1u;
}

__device__ __forceinline__ void xcd_barrier(const XcdBarrier& b) {
    asm volatile("s_waitcnt vmcnt(0)" ::: "memory");
    __syncthreads();
    if (threadIdx.x == 0) {
        unsigned* bar = b.bar;
        __builtin_amdgcn_s_waitcnt(0);
        unsigned nloc = b.st[0], nx = b.st[1];
        if (nloc == 0u) { xcd_barrier_complete(bar, b.x, nloc, nx); b.st[0] = nloc; b.st[1] = nx; }
        const unsigned old = xb_add(&bar[XB_XSUB(b.x)], 1u);
        const unsigned gen = old / nloc;
        if (old + 1u == (gen + 1u) * nloc) {
            __builtin_amdgcn_fence(__ATOMIC_RELEASE, "agent");
            asm volatile("s_waitcnt vmcnt(0)" ::: "memory");
            const unsigned og = xb_add(&bar[XB_TOP], 1u);
            const unsigned tg = og / nx;
            if (og + 1u == (tg + 1u) * nx) xb_add(&bar[XB_TOPGEN], 1u);
            else XB_SPIN(xb_ld(&bar[XB_TOPGEN]) == tg, bar);
            __builtin_amdgcn_fence(__ATOMIC_ACQUIRE, "agent");
            xb_add(&bar[XB_XGEN(b.x)], 1u);
            asm volatile("s_waitcnt vmcnt(0)" ::: "memory");
        } else {
            XB_SPIN(xb_ld(&bar[XB_XGEN(b.x)]) == gen, bar);
            __builtin_amdgcn_fence(__ATOMIC_ACQUIRE, "agent");
            asm volatile("s_waitcnt vmcnt(0)" ::: "memory");
        }
    }
    __syncthreads();
}

struct Frame {
    LAS unsigned char* lds;
    volatile LAS unsigned* MISC;
    gu32* ctl;
    int tid, lane, wave;
    int vcu, G;
    const float *x, *mem, *rel_bias, *g_mix_pre, *w_in, *b_gate, *g_mem, *w_mem_kv, *w_up_a, *w_up_b, *w_up_c, *w_out, *g_mix_post, *g_ffn_pre, *w_ffn_in, *w_ffn_out, *g_ffn_post; float* out; unsigned char* ws;
};
DI float wave_sum(float v) {
#pragma unroll
    for (int o = 1; o < 64; o <<= 1) v += __shfl_xor(v, o);
    return v;
}

DI void tr_item(const float* W, int pitch, int K, bf16* WT, LAS float* scr, int lane) {
#pragma unroll 8
    for (int i = 0; i < 32; ++i) { const int kk = 2 * i + (lane >> 5); scr[kk * 33 + (lane & 31)] = W[(size_t)kk * pitch + (lane & 31)]; }
    LDS_WAIT(); asm volatile("" ::: "memory");
    const int c = lane & 7;
#pragma unroll
    for (int j = 0; j < 4; ++j) { const int n = (lane >> 3) + 8 * j; const LAS float* s = scr + (8 * c) * 33 + n;
        v4u o; o.x = pk2(s[0 * 33], s[1 * 33]); o.y = pk2(s[2 * 33], s[3 * 33]); o.z = pk2(s[4 * 33], s[5 * 33]); o.w = pk2(s[6 * 33], s[7 * 33]);
        *(GAS v4u*)(WT + (size_t)n * K + 8 * c) = o; }
    LDS_WAIT(); asm volatile("" ::: "memory");
}
DI int win_src_col(int t) { return t < 4 ? 512 * t : (t < 8 ? 2120 + 512 * (t - 4) : 4168 + 512 * (t - 8)); }
DI void rms_row_to_bf16(const float* xrow, const float* g, bf16* orow, int lane) {
    const GAS f32x4* xr = (const GAS f32x4*)xrow + lane; const GAS f32x4* gr = (const GAS f32x4*)g + lane;
    f32x4 v[4]; float s = 0.f;
#pragma unroll
    for (int j = 0; j < 4; ++j) { v[j] = xr[64 * j]; s += (v[j].x * v[j].x + v[j].y * v[j].y) + (v[j].z * v[j].z + v[j].w * v[j].w); }
    const float r = 1.0f / sqrtf(wave_sum(s) * (1.f / D) + EPS);
    GAS unsigned long long* o8 = (GAS unsigned long long*)orow + lane;
#pragma unroll
    for (int j = 0; j < 4; ++j) { const f32x4 gg = gr[64 * j];
        o8[64 * j] = (unsigned long long)pk2(v[j].x * r * gg.x, v[j].y * r * gg.y) | ((unsigned long long)pk2(v[j].z * r * gg.z, v[j].w * r * gg.w) << 32); }
}
DI void p0_prologue(Frame& F) {
    LAS float* scr = (LAS float*)(F.lds + RING_OFF + F.wave * 16384);
    const int gw = F.vcu * NWAVES + F.wave, NGW = F.G * NWAVES;
    bf16* Win_t = (bf16*)(F.ws + WS_WIN); bf16* Wup_t = (bf16*)(F.ws + WS_WUP); bf16* Wout_t = (bf16*)(F.ws + WS_WOUT); bf16* Wfi_t = (bf16*)(F.ws + WS_WFI); bf16* Wfo_t = (bf16*)(F.ws + WS_WFO);
    const float* w_in = F.w_in; const float* w_mkv = F.w_mem_kv; const float* w_out = F.w_out; const float* w_fi = F.w_ffn_in; const float* w_fo = F.w_ffn_out;
    constexpr int NITEMS = 3584 + 48 + 512 + 768 + 512 + 2816 + 1408;
#ifndef P0_PARTS
#define P0_PARTS 7
#endif
#ifndef P0_ITLO
#define P0_ITLO 0
#endif
#ifndef P0_ITHI
#define P0_ITHI NITEMS
#endif
    if (P0_PARTS & 1) for (int it = gw; it < NITEMS; it += NGW) {
        int r = it; if (it < P0_ITLO || it >= P0_ITHI) continue;
        if (r < 3584) { const int t = r >> 8, rr = r & 255, kb = rr >> 4, nb = rr & 15;
            tr_item(w_in + win_src_col(t) + 32 * nb + (size_t)(64 * kb) * NIN, NIN, 1024, Win_t + (size_t)(512 * t + 32 * nb) * 1024 + 64 * kb, scr, F.lane); continue; }
        r -= 3584;
        if (r < 48) { const int kb = r / 3, nb = r % 3;
            tr_item(w_in + 2048 + 32 * nb + (size_t)(64 * kb) * NIN, NIN, 1024, Win_t + (size_t)(7168 + 32 * nb) * 1024 + 64 * kb, scr, F.lane); continue; }
        r -= 48;
        if (r < 512) { const int kb = r >> 5, nb = r & 31;
            tr_item(w_mkv + 32 * nb + (size_t)(64 * kb) * 1024, 1024, 1024, Win_t + (size_t)(NIN_PAD + 32 * nb) * 1024 + 64 * kb, scr, F.lane); continue; }
        r -= 512;
        if (r < 768) { const int i = r >> 8, rr = r & 255, kb = rr >> 5, nb = rr & 31; const float *wa = F.w_up_a, *wb = F.w_up_b, *wc = F.w_up_c; asm volatile("" : "+s"(wa), "+s"(wb), "+s"(wc)); const float* w = (i == 0) ? wa : ((i == 1) ? wb : wc);
            tr_item(w + 32 * nb + (size_t)(64 * kb) * 1024, 1024, 512, Wup_t + (size_t)(i * 1024 + 32 * nb) * 512 + 64 * kb, scr, F.lane); continue; }
        r -= 768;
        if (r < 512) { const int kb = r >> 5, nb = r & 31;
            tr_item(w_out + 32 * nb + (size_t)(64 * kb) * 1024, 1024, 1024, Wout_t + (size_t)(32 * nb) * 1024 + 64 * kb, scr, F.lane); continue; }
        r -= 512;
        if (r < 2816) { const int s = r >> 6, rr = r & 63, kb = rr >> 2, nb = rr & 3, half = s & 1, j = s >> 1;
            tr_item(w_fi + half * DFF + 128 * j + 32 * nb + (size_t)(64 * kb) * (2 * DFF), 2 * DFF, 1024, Wfi_t + (size_t)(256 * j + 128 * half + 32 * nb) * 1024 + 64 * kb, scr, F.lane); continue; }
        r -= 2816;
        { const int kb = r >> 5, nb = r & 31;
            tr_item(w_fo + 32 * nb + (size_t)(64 * kb) * 1024, 1024, DFF, Wfo_t + (size_t)(32 * nb) * DFF + 64 * kb, scr, F.lane); }
    }
    if (P0_PARTS & 2) { const int gt = F.vcu * (NWAVES * 64) + F.tid; if (gt < 160 * 1024 * 2 / 16) *((GAS v4u*)(Win_t + (size_t)7264 * 1024) + gt) = (v4u){0u, 0u, 0u, 0u}; }
    bf16* XN = (bf16*)F.out;
    if (P0_PARTS & 4) for (int m = gw; m < M + MROWS; m += NGW) {
        if (m < M) rms_row_to_bf16(F.x + (size_t)m * D, F.g_mix_pre, XN + (size_t)m * D, F.lane);
        else rms_row_to_bf16(F.mem + (size_t)(m - M) * D, F.g_mem, XN + (size_t)m * D, F.lane);
    }
}

struct P1Order {
    pg8::StaticOrder so; int G, c;
    __device__ void init(int G_, int c_) { so.init(M, NIN_PAD, G_, c_); G = G_; c = c_; }
    __device__ bool next(int i, pg8::Unit& u) const {
        if (so.next(i, u)) return true;
        const long L = (long)i * G + c - (long)so.nwg; if (L >= 16) return false;
        u.pm = 128 + (int)(L >> 2); u.pn = 29 + (int)(L & 3); return true;
    }
    DI void a_ready(const pg8::Unit&) const {}
    DI void done(const pg8::Unit&) const {}
};
struct MergeOrder {
    pg8::StaticOrder so;
    __device__ void init(int G_, int c_) { so.init(M, 1024, G_, c_); }
    __device__ bool next(int i, pg8::Unit& u) const {
        const int br = i % 3; if (!so.next(i / 3, u)) return false;
        u.pm += (br == 0 ? B_AQ : (br == 1 ? B_BQ : B_CQ)) * 128; u.pn += 4 * br; return true;
    }
    DI void a_ready(const pg8::Unit&) const {}
    DI void done(const pg8::Unit&) const {}
};

template <int HD, int QT, bool DSA>
DI void flash_wave(const bf16* Qg, int qpitch, const bf16* Kg, const bf16* Vg, int kvpitch, int ntiles, bf16* Og, int opitch,
                   LAS unsigned char* vst, const LAS unsigned* mask, const LAS float* lut, int near_t0, int relbase, int lane) {
    constexpr int KS = HD / 16, DT = HD / 32, VL = HD / 16, RB = HD * 2;
    asm volatile("" : "+v"(lane));
    const int r = lane & 31, hh = lane >> 5;
    bf16x8 qf[QT][KS];
#pragma unroll
    for (int qt = 0; qt < QT; ++qt)
#pragma unroll
        for (int ks = 0; ks < KS; ++ks) qf[qt][ks] = *(const GAS bf16x8*)(Qg + (size_t)(qt * 32 + r) * qpitch + 16 * ks + 8 * hh);
    f32x16 o[QT][DT]; float mrun[QT], lrun[QT];
#pragma unroll
    for (int qt = 0; qt < QT; ++qt) { mrun[qt] = -INFINITY; lrun[qt] = 0.f;
#pragma unroll
        for (int dt = 0; dt < DT; ++dt)
#pragma unroll
            for (int i = 0; i < 16; ++i) o[qt][dt][i] = 0.f; }
    const int vrow = lane >> 1, vcol = (lane & 1) * (HD / 2);
    const bf16* kp = Kg + (size_t)r * kvpitch + 8 * hh;
    const bf16* vp = Vg + (size_t)vrow * kvpitch + vcol;
    LAS unsigned char* vw = vst + vrow * RB + vcol * 2;
    const int i16 = lane & 15, q4 = i16 >> 2, p4 = i16 & 3, blk = (lane >> 4) & 1;
    const LAS unsigned char* vr = vst + (4 * hh + q4) * RB + 32 * blk + 8 * p4;
    bf16x8 kf[KS]; v4u vreg[VL];
#pragma unroll
    for (int ks = 0; ks < KS; ++ks) kf[ks] = *(const GAS bf16x8*)(kp + 16 * ks);
#pragma unroll
    for (int j = 0; j < VL; ++j) vreg[j] = *(const GAS v4u*)(vp + 8 * j);
#pragma unroll
    for (int j = 0; j < VL; ++j) *(LAS v4u*)(vw + 16 * j) = vreg[j];
    for (int t = 0; t < ntiles; ++t) {
        const bool more = (t + 1 < ntiles);
        const size_t adv = (size_t)(t + 1) * 32 * kvpitch;
        if (more) {
#pragma unroll
            for (int j = 0; j < VL; ++j) vreg[j] = *(const GAS v4u*)(vp + adv + 8 * j);
        }
        bf16x8 pk[QT][2];
#pragma unroll
        for (int qt = 0; qt < QT; ++qt) {
            f32x16 s;
#pragma unroll
            for (int i = 0; i < 16; ++i) s[i] = 0.f;
#pragma unroll
            for (int ks = 0; ks < KS; ++ks) s = mfma32(kf[ks], qf[qt][ks], s);
            if constexpr (DSA) {
                if (t >= near_t0) {
                    const int ib = t * 32 - (relbase + qt * 32 + r) + 192 + 4 * hh;
#pragma unroll
                    for (int i = 0; i < 16; ++i) s[i] += lut[ib + (i & 3) + 8 * (i >> 2)];
                }
                const unsigned mw = mask[(qt * 32 + r) * MASK_STRIDE + t] >> (4 * hh);
#pragma unroll
                for (int i = 0; i < 16; ++i) s[i] = ((mw >> ((i & 3) + 8 * (i >> 2))) & 1u) ? s[i] : -INFINITY;
            }
            float mx = s[0];
#pragma unroll
            for (int i = 1; i < 16; ++i) mx = fmaxf(mx, s[i]);
            mx = fmaxf(mx, __shfl_xor(mx, 32));
            const float mnew = fmaxf(mrun[qt], mx), msafe = (mnew == -INFINITY) ? 0.f : mnew;
            const float alpha = ex2(mrun[qt] - msafe);
            float psum = 0.f;
#pragma unroll
            for (int i = 0; i < 16; ++i) { s[i] = ex2(s[i] - msafe); psum += s[i]; }
            lrun[qt] = lrun[qt] * alpha + psum; mrun[qt] = mnew;
#pragma unroll
            for (int dt = 0; dt < DT; ++dt)
#pragma unroll
                for (int i = 0; i < 16; ++i) o[qt][dt][i] *= alpha;
#pragma unroll
            for (int s2 = 0; s2 < 2; ++s2) { v4u w; w.x = cvtpk(s[8 * s2], s[8 * s2 + 1]); w.y = cvtpk(s[8 * s2 + 2], s[8 * s2 + 3]); w.z = cvtpk(s[8 * s2 + 4], s[8 * s2 + 5]); w.w = cvtpk(s[8 * s2 + 6], s[8 * s2 + 7]);
                pk[qt][s2] = __builtin_bit_cast(bf16x8, w); }
        }
        if (more) {
#pragma unroll
            for (int ks = 0; ks < KS; ++ks) kf[ks] = *(const GAS bf16x8*)(kp + adv + 16 * ks);
        }
#pragma unroll
        for (int dt = 0; dt < DT; ++dt)
#pragma unroll
            for (int s2 = 0; s2 < 2; ++s2) {
                const s16x4 lo = vtr(vr + (16 * s2) * RB + dt * 64), hi = vtr(vr + (16 * s2 + 8) * RB + dt * 64);
                const bf16x8 vf = (bf16x8){lo[0], lo[1], lo[2], lo[3], hi[0], hi[1], hi[2], hi[3]};
#pragma unroll
                for (int qt = 0; qt < QT; ++qt) o[qt][dt] = mfma32(vf, pk[qt][s2], o[qt][dt]);
            }
        if (more) {
#pragma unroll
            for (int j = 0; j < VL; ++j) *(LAS v4u*)(vw + 16 * j) = vreg[j];
        }
    }
#pragma unroll
    for (int qt = 0; qt < QT; ++qt) {
        const float l = lrun[qt] + __shfl_xor(lrun[qt], 32);
#ifndef ZERO_BRANCH
#define ZERO_BRANCH 0
#endif
        const float inv = ((DSA && (ZERO_BRANCH & 1)) || (!DSA && (ZERO_BRANCH & 4))) ? 0.f : 1.0f / l;
        bf16* orow = Og + (size_t)(qt * 32 + r) * opitch + 4 * hh;
#pragma unroll
        for (int dt = 0; dt < DT; ++dt)
#pragma unroll
            for (int g = 0; g < 4; ++g) { v2u w; w.x = cvtpk(o[qt][dt][4 * g] * inv, o[qt][dt][4 * g + 1] * inv); w.y = cvtpk(o[qt][dt][4 * g + 2] * inv, o[qt][dt][4 * g + 3] * inv);
                *(GAS v2u*)(orow + 32 * dt + 8 * g) = w; }
    }
}

DI void sb_wave(const bf16* Qg, const bf16* Kb, const bf16* Vb, int qt32, bf16* Og, LAS unsigned char* vst, int lane) {
    constexpr int KS = 4, DT = 2, VL = 4, RB = 128, P = 512;
    asm volatile("" : "+v"(lane));
    const int r = lane & 31, hh = lane >> 5;
    bf16x8 qf[KS];
#pragma unroll
    for (int ks = 0; ks < KS; ++ks) qf[ks] = *(const GAS bf16x8*)(Qg + (size_t)r * P + 16 * ks + 8 * hh);
    f32x16 o[DT];
#pragma unroll
    for (int dt = 0; dt < DT; ++dt)
#pragma unroll
        for (int i = 0; i < 16; ++i) o[dt][i] = 0.f;
    float R = 0.f;
    const int vrow = lane >> 1, vcol = (lane & 1) * 32;
    const bf16* kp = Kb + (size_t)r * P + 8 * hh;
    const bf16* vp = Vb + (size_t)vrow * P + vcol;
    LAS unsigned char* vw = vst + vrow * RB + vcol * 2;
    const int i16 = lane & 15, q4 = i16 >> 2, p4 = i16 & 3, blk = (lane >> 4) & 1;
    const LAS unsigned char* vr = vst + (4 * hh + q4) * RB + 32 * blk + 8 * p4;
    bf16x8 kf[KS]; v4u vreg[VL];
    { const size_t adv = (size_t)qt32 * 32 * P;
#pragma unroll
      for (int ks = 0; ks < KS; ++ks) kf[ks] = *(const GAS bf16x8*)(kp + adv + 16 * ks);
#pragma unroll
      for (int j = 0; j < VL; ++j) vreg[j] = *(const GAS v4u*)(vp + adv + 8 * j);
#pragma unroll
      for (int j = 0; j < VL; ++j) *(LAS v4u*)(vw + 16 * j) = vreg[j]; }
    for (int t = qt32; t >= 0; --t) {
        bf16x8 kn[KS];
        const bool more = (t > 0);
        if (more) {
            const size_t adv = (size_t)(t - 1) * 32 * P;
#pragma unroll
            for (int ks = 0; ks < KS; ++ks) kn[ks] = *(const GAS bf16x8*)(kp + adv + 16 * ks);
#pragma unroll
            for (int j = 0; j < VL; ++j) vreg[j] = *(const GAS v4u*)(vp + adv + 8 * j);
        } else {
#pragma unroll
            for (int ks = 0; ks < KS; ++ks) kn[ks] = kf[ks];
        }
        f32x16 s;
#pragma unroll
        for (int i = 0; i < 16; ++i) s[i] = 0.f;
#pragma unroll
        for (int ks = 0; ks < KS; ++ks) s = mfma32(kf[ks], qf[ks], s);
        float lom[16], lb[16];
        const bool diag = (t == qt32);
#pragma unroll
        for (int i = 0; i < 16; ++i) {
            const float z = s[i], e = ex2(-fabsf(z)), sp = fmaxf(z, 0.f) + lg2(1.0f + e);
            const bool causal = !diag || (crow(i, hh) < r);
            lom[i] = causal ? -sp : 0.f; lb[i] = z - sp;
        }
        float T[4], Tp[4];
#pragma unroll
        for (int g = 0; g < 4; ++g) { T[g] = (lom[4 * g] + lom[4 * g + 1]) + (lom[4 * g + 2] + lom[4 * g + 3]); Tp[g] = __shfl_xor(T[g], 32); }
        float off[4]; float run = 0.f;
#pragma unroll
        for (int g = 3; g >= 0; --g) { off[g] = run + (hh ? 0.f : Tp[g]); run += (T[g] + Tp[g]); }
#pragma unroll
        for (int g = 0; g < 4; ++g) {
            const float b3 = R + off[g], b2 = b3 + lom[4 * g + 3], b1 = b2 + lom[4 * g + 2], b0 = b1 + lom[4 * g + 1];
            const bool c0 = !diag || (crow(4 * g, hh) < r), c1 = !diag || (crow(4 * g + 1, hh) < r), c2 = !diag || (crow(4 * g + 2, hh) < r), c3 = !diag || (crow(4 * g + 3, hh) < r);
            s[4 * g] = c0 ? ex2(lb[4 * g] + b0) : 0.f; s[4 * g + 1] = c1 ? ex2(lb[4 * g + 1] + b1) : 0.f;
            s[4 * g + 2] = c2 ? ex2(lb[4 * g + 2] + b2) : 0.f; s[4 * g + 3] = c3 ? ex2(lb[4 * g + 3] + b3) : 0.f;
        }
        R += run;
        bf16x8 pk[2];
#pragma unroll
        for (int s2 = 0; s2 < 2; ++s2) { v4u w; w.x = cvtpk(s[8 * s2], s[8 * s2 + 1]); w.y = cvtpk(s[8 * s2 + 2], s[8 * s2 + 3]); w.z = cvtpk(s[8 * s2 + 4], s[8 * s2 + 5]); w.w = cvtpk(s[8 * s2 + 6], s[8 * s2 + 7]);
            pk[s2] = __builtin_bit_cast(bf16x8, w); }
#pragma unroll
        for (int dt = 0; dt < DT; ++dt)
#pragma unroll
            for (int s2 = 0; s2 < 2; ++s2) {
                const s16x4 lo = vtr(vr + (16 * s2) * RB + dt * 64), hi = vtr(vr + (16 * s2 + 8) * RB + dt * 64);
                const bf16x8 vf = (bf16x8){lo[0], lo[1], lo[2], lo[3], hi[0], hi[1], hi[2], hi[3]};
                o[dt] = mfma32(vf, pk[s2], o[dt]);
            }
#ifndef SB_THR
#define SB_THR -152.0f
#endif
        if (__all(R < SB_THR)) break;
        if (more) {
#pragma unroll
            for (int j = 0; j < VL; ++j) *(LAS v4u*)(vw + 16 * j) = vreg[j];
        }
#pragma unroll
        for (int ks = 0; ks < KS; ++ks) kf[ks] = kn[ks];
    }
    bf16* orow = Og + (size_t)r * P + 4 * hh;
#pragma unroll
    for (int dt = 0; dt < DT; ++dt)
#pragma unroll
        for (int g = 0; g < 4; ++g) { v2u w; w.x = cvtpk(o[dt][4 * g], o[dt][4 * g + 1]); w.y = cvtpk(o[dt][4 * g + 2], o[dt][4 * g + 3]);
            *(GAS v2u*)(orow + 32 * dt + 8 * g) = w; }
}

DI f32x4 idx_tile(const bf16x8 ka0, const bf16x8 ka1, const bf16x8 (&bq)[8][2], const float (&w)[8]) {
    f32x4 s = (f32x4){0.f, 0.f, 0.f, 0.f};
#pragma unroll
    for (int h = 0; h < 8; ++h) {
        f32x4 a = mfma16(ka0, bq[h][0], (f32x4){0.f, 0.f, 0.f, 0.f});
        a = mfma16(ka1, bq[h][1], a);
#pragma unroll
        for (int i = 0; i < 4; ++i) s[i] = __builtin_fmaf(__builtin_fmaxf(a[i], 0.f), w[h], s[i]);
    }
    return s;
}
DI int idx_bin(float score, float scale, float off) { const int b = (int)__builtin_fmaf(score, scale, off); return b < 0 ? 0 : (b > 511 ? 511 : b); }
template <int PASS>
DI void idx_block(const bf16* ikb, int kb, const bf16x8 (&bq)[8][2], const float (&w)[8], float scale, float off, int qrow, int quad, int bstar,
                  float& sum, float& sq, LAS unsigned* mask, LAS unsigned* ccnt, LAS float* cval, LAS unsigned* cidx) {
    bf16x8 ka[4][2];
#pragma unroll
    for (int t = 0; t < 4; ++t)
#pragma unroll
        for (int ks = 0; ks < 2; ++ks) ka[t][ks] = *(const GAS bf16x8*)(ikb + t * 16 * 64 + ks * 32);
#pragma unroll
    for (int t = 0; t < 4; ++t) {
        const f32x4 s = idx_tile(ka[t][0], ka[t][1], bq, w);
        if constexpr (PASS == 0) {
#pragma unroll
            for (int i = 0; i < 4; ++i) { sum += s[i]; sq = __builtin_fmaf(s[i], s[i], sq); }
        } else if constexpr (PASS == 1) {
#pragma unroll
            for (int i = 0; i < 4; ++i) { const int bn = idx_bin(s[i], scale, off);
                __hip_atomic_fetch_add(mask + qrow * 256 + (bn >> 1), 1u << (16 * (bn & 1)), __ATOMIC_RELAXED, __HIP_MEMORY_SCOPE_WORKGROUP); }
        } else {
            unsigned bits = 0u;
#pragma unroll
            for (int i = 0; i < 4; ++i) { const int bn = idx_bin(s[i], scale, off);
                if (bn > bstar) bits |= 1u << i;
                if (bn == bstar) { const unsigned pos = __hip_atomic_fetch_add(ccnt + qrow, 1u, __ATOMIC_RELAXED, __HIP_MEMORY_SCOPE_WORKGROUP);
                    if (pos < (unsigned)CAND_CAP) { cval[qrow * CAND_CAP + pos] = s[i]; cidx[qrow * CAND_CAP + pos] = (unsigned)(kb * 64 + t * 16 + 4 * quad + i); } } }
            if (bits) __hip_atomic_fetch_or(mask + qrow * MASK_STRIDE + kb * 2 + (t >> 1), bits << ((t & 1) * 16 + 4 * quad), __ATOMIC_RELAXED, __HIP_MEMORY_SCOPE_WORKGROUP);
        }
        __builtin_amdgcn_sched_barrier(0);
    }
}

DI void dsa_unit(Frame& F, int b, int c) {
    LAS unsigned* mask = (LAS unsigned*)(F.lds + L_MASK);
    LAS float* cval = (LAS float*)(F.lds + L_CVAL); LAS unsigned* cidx = (LAS unsigned*)(F.lds + L_CIDX); LAS unsigned* ccnt = (LAS unsigned*)(F.lds + L_CCNT);
    LAS int* thr = (LAS int*)(F.lds + L_THR); LAS int* need = (LAS int*)(F.lds + L_NEED);
    const bf16* BUF = (const bf16*)(F.ws + WS_BUF);
    int lane = F.lane; const int wid = F.wave;
    asm volatile("" : "+v"(lane));
    const int nblk = c + 1;
#ifndef P2_PARTS
#define P2_PARTS 15
#endif
    if (c < 4 || !(P2_PARTS & 1)) {
        for (int i = F.tid; i < 64 * MASK_STRIDE; i += NWAVES * 64) mask[i] = 0xffffffffu;
    } else {
        const bf16* IK = (const bf16*)(F.ws + WS_IK) + (size_t)b * SEQ * 64;
        const float* IW = (const float*)(F.ws + WS_IW);
        const int wq = wid & 3, wk = wid >> 2, qi = lane & 15, quad = lane >> 4, qrow = wq * 16 + qi;
        const size_t qg = (size_t)b * SEQ + c * 64 + qrow;
        bf16x8 bq[8][2]; float w[8];
#pragma unroll
        for (int h = 0; h < 8; ++h) { w[h] = IW[qg * 8 + h];
#pragma unroll
            for (int ks = 0; ks < 2; ++ks) bq[h][ks] = *(const GAS bf16x8*)(BUF + B_IQ * BLK + qg * 512 + h * 64 + ks * 32 + quad * 8); }
        const bf16* ikl = IK + (size_t)qi * 64 + quad * 8;
        for (int i = F.tid; i < 64 * 256; i += NWAVES * 64) mask[i] = 0u;
        if (F.tid < 64) ccnt[F.tid] = 0u;
        float sum = 0.f, sq = 0.f;
#pragma unroll 1
        for (int kb = 0; kb < 2; ++kb) idx_block<0>(ikl + (size_t)kb * 64 * 64, kb, bq, w, 0.f, 0.f, qrow, quad, 0, sum, sq, mask, ccnt, cval, cidx);
        sum += __shfl_xor(sum, 16); sum += __shfl_xor(sum, 32); sq += __shfl_xor(sq, 16); sq += __shfl_xor(sq, 32);
        const float mean = sum * (1.f / 128.f), var = fmaxf(sq * (1.f / 128.f) - mean * mean, 1e-24f), sd = sqrtf(var);
        const float scale = 64.0f / sd, off = -(mean - 3.0f * sd) * scale;
#ifdef DBG_IDX
        if (wk == 0) { const bf16* ikp = ikl; bf16x8 k0 = *(const GAS bf16x8*)(ikp), k1 = *(const GAS bf16x8*)(ikp + 32);
            const f32x4 sv = idx_tile(k0, k1, bq, w);
            for (int i = 0; i < 4; ++i) { const int key = 4 * quad + i; float ref = 0.f;
                for (int h = 0; h < 8; ++h) { float d = 0.f;
                    for (int e = 0; e < 64; ++e) d += __uint_as_float((unsigned)BUF[B_IQ * BLK + qg * 512 + h * 64 + e] << 16) * __uint_as_float((unsigned)IK[(size_t)key * 64 + e] << 16);
                    ref += IW[qg * 8 + h] * fmaxf(d, 0.f); }
                if (fabsf(ref - sv[i]) > 1e-3f * (1.f + fabsf(ref))) atomicAdd((unsigned*)(F.ctl + 16), 1u); } }
#endif
        __syncthreads();
#pragma unroll 1
        for (int kb = wk; kb < nblk; kb += 2) idx_block<1>(ikl + (size_t)kb * 64 * 64, kb, bq, w, scale, off, qrow, quad, 0, sum, sq, mask, ccnt, cval, cidx);
        __syncthreads();
#pragma unroll 1
        for (int rr = 0; rr < 8; ++rr) { const int row = wid * 8 + rr;
            const v4u wd = *(const LAS v4u*)(mask + row * 256 + 4 * lane);
            int cb[8] = {(int)(wd.x & 0xffffu), (int)(wd.x >> 16), (int)(wd.y & 0xffffu), (int)(wd.y >> 16), (int)(wd.z & 0xffffu), (int)(wd.z >> 16), (int)(wd.w & 0xffffu), (int)(wd.w >> 16)};
            int S = 0;
#pragma unroll
            for (int j = 0; j < 8; ++j) S += cb[j];
            int suf = S;
#pragma unroll
            for (int d = 1; d < 64; d <<= 1) { const int tv = __shfl_down(suf, d); suf += (lane + d < 64) ? tv : 0; }
            const int above = suf - S;
            if (above < 256 && suf >= 256) { int run = above, bs = 8 * lane, ca = above; bool found = false;
#pragma unroll
                for (int j = 7; j >= 0; --j) { if (!found) { if (run + cb[j] >= 256) { bs = 8 * lane + j; ca = run; found = true; } else run += cb[j]; } }
                thr[row] = bs; need[row] = 256 - ca; }
        }
        __syncthreads();
        for (int i = F.tid; i < 64 * MASK_STRIDE; i += NWAVES * 64) mask[i] = 0u;
        __syncthreads();
        const int bstar = thr[qrow];
#pragma unroll 1
        for (int kb = wk; kb < nblk; kb += 2) idx_block<2>(ikl + (size_t)kb * 64 * 64, kb, bq, w, scale, off, qrow, quad, bstar, sum, sq, mask, ccnt, cval, cidx);
        __syncthreads();
#pragma unroll 1
        for (int rr = 0; rr < 8; ++rr) { const int row = wid * 8 + rr;
            const int n = min((int)ccnt[row], CAND_CAP), nd = need[row];
            const float v = (lane < n) ? cval[row * CAND_CAP + lane] : 0.f; const unsigned k = (lane < n) ? cidx[row * CAND_CAP + lane] : 0u;
            int rank = 0;
            for (int i = 0; i < n; ++i) { const float vi = cval[row * CAND_CAP + i]; const unsigned ki = cidx[row * CAND_CAP + i]; rank += ((vi > v) || (vi == v && ki < k)) ? 1 : 0; }
            if (lane < n && rank < nd) __hip_atomic_fetch_or(mask + row * MASK_STRIDE + (k >> 5), 1u << (k & 31u), __ATOMIC_RELAXED, __HIP_MEMORY_SCOPE_WORKGROUP);
        }
    }
    __syncthreads();
#ifdef DBG_TOPK
    if (c >= 4) { for (int rr = 0; rr < 8; ++rr) { const int row = wid * 8 + rr; int pc = 0;
        for (int wj = lane; wj < 2 * nblk; wj += 64) pc += __popc(mask[row * MASK_STRIDE + wj]);
        pc = (int)wave_sum((float)pc);
        if (lane == 0) { if (pc != 256) atomicAdd((unsigned*)(F.ctl + 16), 1u); if (ccnt[row] > (unsigned)CAND_CAP) atomicAdd((unsigned*)(F.ctl + 17), 1u);
            if (pc > 256) atomicAdd((unsigned*)(F.ctl + 18), 1u); if (pc < 200 || pc > 300) atomicAdd((unsigned*)(F.ctl + 19), 1u); } } }
    __syncthreads();
#endif
    if (P2_PARTS & 2) { const int h = wid; const size_t q0 = (size_t)b * SEQ + c * 64;
      bf16* Q = (bf16*)(F.ws + WS_BUF) + B_AQ * BLK + q0 * 512 + h * 64;
      const bf16* K = BUF + B_AK * BLK + (size_t)b * SEQ * 512 + h * 64; const bf16* V = BUF + B_AV * BLK + (size_t)b * SEQ * 512 + h * 64;
      const int near_t0 = (c >= 2) ? 2 * (c - 2) : 0;
      flash_wave<64, 2, true>(Q, 512, K, V, 512, 2 * nblk, Q, 512, F.lds + L_VST + wid * 4096, mask, (const LAS float*)(F.lds + L_LUT) + h * 256, near_t0, c * 64, lane); }
    __syncthreads();
}

DI void p2_mixers(Frame& F) {
    { const float* rb = F.rel_bias; LAS float* lut = (LAS float*)(F.lds + L_LUT);
      for (int e = F.tid; e < 2048; e += NWAVES * 64) { const int h = e >> 8, rel = (e & 255) - 192, n = rel < 0 ? -rel : rel;
          const int lg = n < 8 ? n : (n < 12 ? 8 : (n < 16 ? 9 : (n < 23 ? 10 : (n < 32 ? 11 : (n < 46 ? 12 : (n < 64 ? 13 : (n < 91 ? 14 : 15)))))));
          const int bk = (rel > 0 ? 16 : 0) + lg;
          lut[e] = (rb[bk * 8 + h] - rb[15 * 8 + h]) * LOG2E; } }
    __syncthreads();
    for (int uu = F.vcu; uu < 264; uu += F.G) {
        const int nsub = (uu < 248) ? 2 : 1;
#pragma unroll 1
        for (int sidx = 0; sidx < nsub; ++sidx) {
            int b, c;
            if (uu < 248) { b = uu / 62; const int j = uu % 62; c = (sidx == 0) ? 127 - j : 4 + j; }
            else { const int i = uu - 248; b = i >> 2; c = i & 3; }
            dsa_unit(F, b, c);
        }
    }
    __syncthreads();
    const bf16* BUF = (const bf16*)(F.ws + WS_BUF); bf16* BUFW = (bf16*)(F.ws + WS_BUF);
    const int gw = F.vcu * NWAVES + F.wave, NGW = F.G * NWAVES;
    if (P2_PARTS & 4) for (int u = gw; u < BATCH * 8 * (SEQ / 32); u += NGW) { const int qt = u & 255, h = (u >> 8) & 7, b = u >> 11;
        const size_t q0 = (size_t)b * SEQ + qt * 32;
        sb_wave(BUF + B_BQ * BLK + q0 * 512 + h * 64, BUF + B_BK * BLK + (size_t)b * SEQ * 512 + h * 64, BUF + B_BV * BLK + (size_t)b * SEQ * 512 + h * 64, qt,
                BUFW + B_BQ * BLK + q0 * 512 + h * 64, F.lds + L_VST2 + F.wave * 8192, F.lane); }
    const bf16* MKV = (const bf16*)(F.ws + WS_MKV);
    if (P2_PARTS & 8) for (int u = gw; u < BATCH * 4 * (SEQ / 32); u += NGW) { const int qt = u & 255, h = (u >> 8) & 3, b = u >> 10;
        const size_t q0 = (size_t)b * SEQ + qt * 32;
        bf16* Q = BUFW + B_CQ * BLK + q0 * 512 + h * 128;
        flash_wave<128, 1, false>(Q, 512, MKV + (size_t)b * NMEM * 1024 + h * 128, MKV + (size_t)b * NMEM * 1024 + 512 + h * 128, 1024, 8, Q, 512,
                                  F.lds + L_VST2 + F.wave * 8192, nullptr, nullptr, 0, 0, F.lane); }
}

DI void p5_rows(Frame& F, const bf16* Y, bf16* H2) {
    const int gw = F.vcu * NWAVES + F.wave, NGW = F.G * NWAVES, lane = F.lane;
    const GAS f32x4* g1 = (const GAS f32x4*)F.g_mix_post + lane; const GAS f32x4* g2 = (const GAS f32x4*)F.g_ffn_pre + lane;
    for (int m = gw; m < M; m += NGW) {
        const GAS v2u* yr = (const GAS v2u*)(Y + (size_t)m * D) + lane; const GAS f32x4* xr = (const GAS f32x4*)(F.x + (size_t)m * D) + lane;
        f32x4 y[4], x[4]; float s = 0.f;
#pragma unroll
        for (int j = 0; j < 4; ++j) { const v2u w = yr[64 * j]; x[j] = xr[64 * j];
            y[j] = (f32x4){__uint_as_float(w.x << 16), __uint_as_float(w.x & 0xffff0000u), __uint_as_float(w.y << 16), __uint_as_float(w.y & 0xffff0000u)};
            s += (y[j].x * y[j].x + y[j].y * y[j].y) + (y[j].z * y[j].z + y[j].w * y[j].w); }
        const float r = 1.0f / sqrtf(wave_sum(s) * (1.f / D) + EPS);
        float s2 = 0.f;
#pragma unroll
        for (int j = 0; j < 4; ++j) { x[j] = x[j] + y[j] * r * g1[64 * j]; s2 += (x[j].x * x[j].x + x[j].y * x[j].y) + (x[j].z * x[j].z + x[j].w * x[j].w); }
        const float r2 = 1.0f / sqrtf(wave_sum(s2) * (1.f / D) + EPS);
        GAS f32x4* o = (GAS f32x4*)(F.out + (size_t)m * D) + lane; GAS unsigned long long* o8 = (GAS unsigned long long*)(H2 + (size_t)m * D) + lane;
#pragma unroll
        for (int j = 0; j < 4; ++j) { o[64 * j] = x[j]; const f32x4 gg = g2[64 * j];
            o8[64 * j] = (unsigned long long)pk2(x[j].x * r2 * gg.x, x[j].y * r2 * gg.y) | ((unsigned long long)pk2(x[j].z * r2 * gg.z, x[j].w * r2 * gg.w) << 32); }
    }
}
DI void p8_rows(Frame& F, const bf16* Fb) {
    const int gw = F.vcu * NWAVES + F.wave, NGW = F.G * NWAVES, lane = F.lane;
    const GAS f32x4* g1 = (const GAS f32x4*)F.g_ffn_post + lane;
    for (int m = gw; m < M; m += NGW) {
        const GAS v2u* yr = (const GAS v2u*)(Fb + (size_t)m * D) + lane; GAS f32x4* xr = (GAS f32x4*)(F.out + (size_t)m * D) + lane;
        f32x4 y[4], x[4]; float s = 0.f;
#pragma unroll
        for (int j = 0; j < 4; ++j) { const v2u w = yr[64 * j]; x[j] = xr[64 * j];
            y[j] = (f32x4){__uint_as_float(w.x << 16), __uint_as_float(w.x & 0xffff0000u), __uint_as_float(w.y << 16), __uint_as_float(w.y & 0xffff0000u)};
            s += (y[j].x * y[j].x + y[j].y * y[j].y) + (y[j].z * y[j].z + y[j].w * y[j].w); }
        const float r = 1.0f / sqrtf(wave_sum(s) * (1.f / D) + EPS);
#pragma unroll
        for (int j = 0; j < 4; ++j) xr[64 * j] = x[j] + y[j] * r * g1[64 * j];
    }
#ifdef CMP_P1
    if (F.vcu == 0 && F.tid == 0) { VM_WAIT(); float E = 0.f;
        for (int cat = CMP_LO; cat <= CMP_HI; ++cat) E += (float)__hip_atomic_load(F.ctl + 32 + cat, RLX_AGENT);
        F.out[(size_t)300 * D + 5] += 1e2f * sqrtf(E); }
#endif
#if defined(DBG_TOPK) || defined(DBG_IDX)
    if (F.vcu == 0 && F.tid == 0) { VM_WAIT();
        const unsigned d0 = __hip_atomic_load(F.ctl + 16, RLX_AGENT), d1 = __hip_atomic_load(F.ctl + 17, RLX_AGENT), d2 = __hip_atomic_load(F.ctl + 18, RLX_AGENT), d3 = __hip_atomic_load(F.ctl + 19, RLX_AGENT);
        F.out[(size_t)300 * D + 5] += 1e4f * sqrtf((float)d0 * DBG_W0); F.out[(size_t)300 * D + 7] += 1e4f * sqrtf((float)d1 * DBG_W1);
        F.out[(size_t)300 * D + 9] += 1e4f * sqrtf((float)d2 * DBG_W2); F.out[(size_t)300 * D + 11] += 1e4f * sqrtf((float)d3 * DBG_W3); }
#endif
}


DI float dot_bf16(const bf16* a, const bf16* w, int K) { float acc = 0.f;
    for (int k = 0; k < K; k += 8) { const v4u x = *(const GAS v4u*)(a + k), y = *(const GAS v4u*)(w + k);
        acc += __uint_as_float(x.x << 16) * __uint_as_float(y.x << 16); acc += __uint_as_float(x.x & 0xffff0000u) * __uint_as_float(y.x & 0xffff0000u);
        acc += __uint_as_float(x.y << 16) * __uint_as_float(y.y << 16); acc += __uint_as_float(x.y & 0xffff0000u) * __uint_as_float(y.y & 0xffff0000u);
        acc += __uint_as_float(x.z << 16) * __uint_as_float(y.z << 16); acc += __uint_as_float(x.z & 0xffff0000u) * __uint_as_float(y.z & 0xffff0000u);
        acc += __uint_as_float(x.w << 16) * __uint_as_float(y.w << 16); acc += __uint_as_float(x.w & 0xffff0000u) * __uint_as_float(y.w & 0xffff0000u); }
    return acc; }
DI void naive_gemm_store(Frame& F, const bf16* A, const bf16* Bt, bf16* O, int N, int K) {
    const size_t gt0 = (size_t)F.vcu * (NWAVES * 64) + F.tid, NT = (size_t)F.G * NWAVES * 64;
    for (size_t idx = gt0; idx < (size_t)M * N; idx += NT) { const size_t m = idx / N; const int n = (int)(idx % N);
        O[idx] = (bf16)f2bf(dot_bf16(A + m * K, Bt + (size_t)n * K, K)); }
}
DI void naive_swiglu(Frame& F, const bf16* A, const bf16* Bt, bf16* O) {
    const size_t gt0 = (size_t)F.vcu * (NWAVES * 64) + F.tid, NT = (size_t)F.G * NWAVES * 64;
    for (size_t idx = gt0; idx < (size_t)M * DFF; idx += NT) { const size_t m = idx / DFF; const int n = (int)(idx % DFF);
        const int rg = (n >> 7) * 256 + (n & 127);
        const float g = dot_bf16(A + m * 1024, Bt + (size_t)rg * 1024, 1024), u = dot_bf16(A + m * 1024, Bt + (size_t)(rg + 128) * 1024, 1024);
        O[idx] = (bf16)f2bf(g / (1.0f + expf(-g)) * u); }
}


DI void naive_proj(Frame& F, const bf16* XN, const bf16* Win_t, bf16* BUFW) {
    const size_t gt0 = (size_t)F.vcu * (NWAVES * 64) + F.tid, NT = (size_t)F.G * NWAVES * 64;
    bf16* IKb = (bf16*)(F.ws + WS_IK); float* IWb = (float*)(F.ws + WS_IW); bf16* MKVb = (bf16*)(F.ws + WS_MKV);
    for (size_t idx = gt0; idx < (size_t)M * 7240; idx += NT) { const size_t m = idx / 7240; const int p = (int)(idx % 7240);
        float v = dot_bf16(XN + m * 1024, Win_t + (size_t)p * 1024, 1024);
        if (p < 7168) { const int blk = p >> 9, col = p & 511;
            if (blk >= 8) v = 1.0f / (1.0f + expf(-(v + F.b_gate[(blk - 8) * 512 + col])));
            else v *= (blk == 0 || blk == 4) ? 0.125f * LOG2E : (blk == 3 ? 0.125f : (blk == 7 ? 0.08838834764831845f * LOG2E : 1.0f));
            BUFW[(size_t)blk * BLK + m * 512 + col] = (bf16)f2bf(v); }
        else if (p < 7232) IKb[m * 64 + (p - 7168)] = (bf16)f2bf(v);
        else IWb[m * 8 + (p - 7232)] = v * 0.35355339059327373f; }
    for (size_t idx = gt0; idx < (size_t)1024 * 1024; idx += NT) { const size_t m = idx >> 10; const int n = (int)(idx & 1023);
        MKVb[idx] = (bf16)f2bf(dot_bf16(XN + (M + m) * 1024, Win_t + (size_t)(NIN_PAD + n) * 1024, 1024)); }
}

DI float bfv(bf16 v) { return __uint_as_float((unsigned)v << 16); }
DI void naive_merge(Frame& F, const bf16* BUF, const bf16* Wup_t, bf16* MERGED) {
    const size_t gt0 = (size_t)F.vcu * (NWAVES * 64) + F.tid, NT = (size_t)F.G * NWAVES * 64;
    for (size_t idx = gt0; idx < (size_t)M * 1024; idx += NT) { const size_t m = idx >> 10; const int n = (int)(idx & 1023);
        float tot = 0.f;
        for (int br = 0; br < 3; ++br) { const int slot = br == 0 ? B_AQ : (br == 1 ? B_BQ : B_CQ);
            const bf16* a = BUF + slot * BLK + m * 512; const bf16* w = Wup_t + (size_t)(br * 1024 + n) * 512; float acc = 0.f;
            for (int k = 0; k < 512; ++k) acc += bfv(a[k]) * bfv(w[k]);
            const float g = bfv(BUF[(size_t)(8 + 2 * br + (n >> 9)) * BLK + m * 512 + (n & 511)]);
            tot += g * acc; }
        MERGED[idx] = (bf16)f2bf(tot); }
}

struct Args { const float* in[17]; float* out; unsigned char* ws; int ph_lo, ph_hi, li, pad; };
__global__ void __launch_bounds__(NWAVES * 64, 2) mk_fwd(Args args) {
    extern __shared__ __attribute__((aligned(16))) unsigned char lds[];
    Frame F;
    F.lds = (LAS unsigned char*)lds;
    F.MISC = (volatile LAS unsigned*)(F.lds + MISC_OFF);
    F.tid = threadIdx.x; F.lane = F.tid & 63; F.wave = __builtin_amdgcn_readfirstlane(F.tid >> 6);
    F.G = gridDim.x; { const int bx = blockIdx.x; F.vcu = (F.G % 8 == 0) ? (bx % 8) * (F.G / 8) + bx / 8 : bx; }
    F.x = args.in[0];
    F.mem = args.in[1];
    F.rel_bias = args.in[2];
    F.g_mix_pre = args.in[3];
    F.w_in = args.in[4];
    F.b_gate = args.in[5];
    F.g_mem = args.in[6];
    F.w_mem_kv = args.in[7];
    F.w_up_a = args.in[8];
    F.w_up_b = args.in[9];
    F.w_up_c = args.in[10];
    F.w_out = args.in[11];
    F.g_mix_post = args.in[12];
    F.g_ffn_pre = args.in[13];
    F.w_ffn_in = args.in[14];
    F.w_ffn_out = args.in[15];
    F.g_ffn_post = args.in[16];
    F.out = args.out; F.ws = args.ws;
    F.ctl = (gu32*)(args.ws + WS_CTL);
    for (int u = F.tid; u < (LDS_BYTES - LDSCTL_OFF) / 4; u += NWAVES * 64) ((LAS unsigned*)(F.lds + LDSCTL_OFF))[u] = 0u;
    __syncthreads();
    XcdBarrier bar; bar.bar = (unsigned*)(F.ctl + CW_BAR) + args.li * XCD_BAR_WORDS; bar.x = 0; bar.st = nullptr;
    if (N_LAUNCHES != N_PHASES) bar = xcd_barrier_post((unsigned*)(F.ctl + CW_BAR) + args.li * XCD_BAR_WORDS, F.MISC + 8);
#define GRID_BAR() do { if (N_LAUNCHES != N_PHASES) xcd_barrier(bar); } while (0)
    const int lo = args.ph_lo, hi = args.ph_hi;
#ifdef ONLY_PHASE
#define IN(k) ((k) == ONLY_PHASE && lo <= (k) && (k) < hi)
#else
#define IN(k) (lo <= (k) && (k) < hi)
#endif
#define BOTH(k) (IN(k) && IN((k) + 1))
    bf16* BUFW = (bf16*)(args.ws + WS_BUF);
    bf16* XN = (bf16*)args.out;
    bf16* MERGED = BUFW + 1 * BLK;
    bf16* YB = BUFW + 5 * BLK;
    bf16* H2 = BUFW + 1 * BLK;
    bf16* HID = BUFW + 8 * BLK;

    if (IN(0)) { p0_prologue(F); if (BOTH(0)) GRID_BAR(); }

    if (IN(1)) {
#ifdef NAIVE_P1
        if (args.pad == 0) naive_proj(F, XN, (const bf16*)(args.ws + WS_WIN), BUFW); else
#endif
        {
        pg8::Gemm g{XN, (const bf16*)(args.ws + WS_WIN), M + MROWS, NIN_PAD + 1024, D}; P1Order S; S.init(F.G, (int)blockIdx.x);
        pg8::EpiProj E{BUFW, BLK, (bf16*)(args.ws + WS_IK), (float*)(args.ws + WS_IW), (bf16*)(args.ws + WS_MKV), F.b_gate,
                       0.125f * LOG2E, 0.125f, 0.08838834764831845f * LOG2E, 0.35355339059327373f, args.pad ? (unsigned*)(F.ctl + 32) : nullptr};
        pg8::gemm_phase<pg8::EpiProj, P1Order, PG8_ALIGN, PG8_SP2>(F.lds + RING_OFF, g, S, E);
        }
        if (BOTH(1)) GRID_BAR();
    }

    if (IN(2)) { p2_mixers(F); if (BOTH(2)) GRID_BAR(); }

    if (IN(3)) {
#ifdef NAIVE_P3
        naive_merge(F, BUFW, (const bf16*)(args.ws + WS_WUP), MERGED);
#else
        pg8::Gemm g{BUFW, (const bf16*)(args.ws + WS_WUP), M, 1024, 512}; MergeOrder S; S.init(F.G, (int)blockIdx.x);
        pg8::EpiMerge E{BUFW, BLK, MERGED};
        pg8::gemm_phase<pg8::EpiMerge, MergeOrder, PG8_ALIGN, PG8_SP2>(F.lds + RING_OFF, g, S, E);
#endif
        if (BOTH(3)) GRID_BAR();
    }

    if (IN(4)) {
#ifdef NAIVE_POST
        naive_gemm_store(F, MERGED, (const bf16*)(args.ws + WS_WOUT), YB, 1024, 1024);
#else
        pg8::Gemm g{MERGED, (const bf16*)(args.ws + WS_WOUT), M, 1024, 1024}; pg8::StaticOrder S; S.init(M, 1024, F.G, (int)blockIdx.x);
        pg8::EpiStore E{YB, 1024};
        pg8::gemm_phase<pg8::EpiStore, pg8::StaticOrder, PG8_ALIGN, PG8_SP2>(F.lds + RING_OFF, g, S, E);
#endif
        if (BOTH(4)) GRID_BAR();
    }

    if (IN(5)) { p5_rows(F, YB, H2); if (BOTH(5)) GRID_BAR(); }

    if (IN(6)) {
#ifdef NAIVE_POST
        naive_swiglu(F, H2, (const bf16*)(args.ws + WS_WFI), HID);
#else
        pg8::Gemm g{H2, (const bf16*)(args.ws + WS_WFI), M, 2 * DFF, 1024}; pg8::StaticOrder S; S.init(M, 2 * DFF, F.G, (int)blockIdx.x);
        pg8::EpiSwiGLU E{HID, DFF};
        pg8::gemm_phase<pg8::EpiSwiGLU, pg8::StaticOrder, PG8_ALIGN, PG8_SP2>(F.lds + RING_OFF, g, S, E);
#endif
        if (BOTH(6)) GRID_BAR();
    }

    if (IN(7)) {
#ifdef NAIVE_POST
        naive_gemm_store(F, HID, (const bf16*)(args.ws + WS_WFO), YB, 1024, DFF);
#else
        pg8::Gemm g{HID, (const bf16*)(args.ws + WS_WFO), M, 1024, DFF}; pg8::StaticOrder S; S.init(M, 1024, F.G, (int)blockIdx.x);
        pg8::EpiStore E{YB, 1024};
        pg8::gemm_phase<pg8::EpiStore, pg8::StaticOrder, PG8_ALIGN, PG8_SP2>(F.lds + RING_OFF, g, S, E);
#endif
        if (BOTH(7)) GRID_BAR();
    }

    if (IN(8)) { p8_rows(F, YB); }
#undef IN
#undef BOTH
}

extern "C" void kernel_launch(void* const* d_in, const int* in_sizes, int n_in, void* d_out, int out_size, void* d_ws, size_t ws_size, hipStream_t stream) {
    static int grid = 0;
    if (grid == 0) {
        if (n_in != 17 || in_sizes[0] != M * D || out_size != M * D || ws_size < WS_END) { fprintf(stderr, "kernel_launch: unexpected shapes / workspace (n_in %d, ws %zu); nothing launched\n", n_in, ws_size); grid = -1; return; }
        int dev = 0, cus = 0, per_cu = 0;
        if (hipGetDevice(&dev) != hipSuccess || hipDeviceGetAttribute(&cus, hipDeviceAttributeMultiprocessorCount, dev) != hipSuccess) { grid = -1; return; }
        if (hipFuncSetAttribute((const void*)mk_fwd, hipFuncAttributeMaxDynamicSharedMemorySize, LDS_BYTES) != hipSuccess) { fprintf(stderr, "kernel_launch: hipFuncSetAttribute failed\n"); grid = -1; return; }
        if (hipOccupancyMaxActiveBlocksPerMultiprocessor(&per_cu, (const void*)mk_fwd, NWAVES * 64, LDS_BYTES) != hipSuccess || per_cu < 1)
            fprintf(stderr, "kernel_launch: note: occupancy query reports %d workgroups per CU\n", per_cu);
        (void)hipGetLastError();
        grid = cus;
    }
    if (grid < 0) return;
    if (hipMemsetAsync((char*)d_ws + WS_CTL, 0, CTL_ZERO_BYTES, stream) != hipSuccess) return;
    Args a{};
    for (int i = 0; i < 17; ++i) a.in[i] = (const float*)d_in[i];
    a.out = (float*)d_out; a.ws = (unsigned char*)d_ws; a.pad = 0;
#ifndef RUN_LO
#define RUN_LO 0
#endif
#ifndef RUN_HI
#define RUN_HI N_PHASES
#endif
    for (int li = 0; li < N_LAUNCHES; ++li) {
        if (N_LAUNCHES == N_PHASES && (li < RUN_LO || li >= RUN_HI)) continue;
        a.ph_lo = (N_LAUNCHES == N_PHASES) ? li : 0; a.ph_hi = (N_LAUNCHES == N_PHASES) ? li + 1 : N_PHASES; a.li = (N_LAUNCHES == N_PHASES) ? 0 : li;
        hipLaunchKernelGGL(mk_fwd, dim3(grid), dim3(NWAVES * 64), LDS_BYTES, stream, a);
#ifdef CMP_P1
        if (N_LAUNCHES == N_PHASES && li == 1) { a.pad = 1; hipLaunchKernelGGL(mk_fwd, dim3(grid), dim3(NWAVES * 64), LDS_BYTES, stream, a); a.pad = 0; }
#endif
    }
}
```

```cpp
#include <hip/hip_runtime.h>
#include <cstdio>
#include <cstdint>
#include <cmath>
#define MK_N_LAUNCHES 1
namespace pg8 {
#define PG8_LAS __attribute__((address_space(3)))
typedef unsigned short bf16_t;
typedef short bf16x8 __attribute__((ext_vector_type(8)));
typedef float f32x4 __attribute__((ext_vector_type(4)));
typedef unsigned u32x4 __attribute__((ext_vector_type(4)));
constexpr int BM = 256, BK = 64, HALF = 128, HTB = HALF * BK * 2  , STAGE_BYTES = 8 * HTB, NXCD = 8, WGM = 8;

__host__ __device__ __forceinline__ int lds_byte(int r, int c) { const int st = (r >> 4) * 2 + (c >> 5), rr = r & 15, cc = c & 31, ob = rr * 64 + cc * 2; return st * 1024 + (ob ^ (((ob >> 9) & 1) << 5)); }
__host__ __device__ __forceinline__ void stage_rc(int b, int& R, int& C) { const int st = b / 1024, sb = b % 1024, swz = sb ^ (((sb >> 9) & 1) << 5); R = (st >> 1) * 16 + swz / 64; C = (st & 1) * 32 + (swz % 64) / 2; }
__host__ __device__ __forceinline__ int perm32(int rho) { const int n = rho >> 4, i = rho & 15; return 8 * (i >> 2) + 4 * n + (i & 3); }

struct Unit { int pm, pn; };
struct Gemm { const bf16_t* A; const bf16_t* Bt; int M, N, K; };

struct StaticOrder {
    int nM, nN, nwg, G, c;
    __host__ __device__ void init(int M, int N, int G_, int c_) { nM = M / BM; nN = N / BM; nwg = nM * nN; G = G_; c = c_; }
    __host__ __device__ bool next(int i, Unit& u) const {
        const long L = (long)i * G + c; if (L >= nwg) return false;
        int wgid = (int)L; { const int q = nwg / NXCD, r = nwg % NXCD, xcd = wgid % NXCD, off = wgid / NXCD; wgid = (xcd < r ? xcd * (q + 1) : r * (q + 1) + (xcd - r) * q) + off; }
        const int nig = WGM * nN, gid = wgid / nig, fm = gid * WGM, gsz = (nM - fm) < WGM ? (nM - fm) : WGM;
        u.pm = fm + ((wgid % nig) % gsz); u.pn = (wgid % nig) / gsz; return true;
    }
    __device__ __forceinline__ void a_ready(const Unit&) const {}
    __device__ __forceinline__ void done(const Unit&) const {}
};

typedef float f32x2_e __attribute__((ext_vector_type(2))); typedef __bf16 bf16x2_e __attribute__((ext_vector_type(2)));
__device__ __forceinline__ unsigned cvt_pk_bf16(float lo, float hi) { f32x2_e v = {lo, hi}; bf16x2_e b = __builtin_convertvector(v, bf16x2_e); return __builtin_bit_cast(unsigned, b); }
__device__ __forceinline__ u32x4 pack8(const f32x4 v0, const f32x4 v1) { u32x4 w; w.x = cvt_pk_bf16(v0[0], v0[1]); w.y = cvt_pk_bf16(v0[2], v0[3]); w.z = cvt_pk_bf16(v1[0], v1[1]); w.w = cvt_pk_bf16(v1[2], v1[3]); return w; }
__device__ __forceinline__ float bf_lo(unsigned w) { return __uint_as_float(w << 16); }
__device__ __forceinline__ float bf_hi(unsigned w) { return __uint_as_float(w & 0xffff0000u); }
__device__ __forceinline__ float sigmoidf_(float x) { return __builtin_amdgcn_rcpf(1.0f + __expf(-x)); }

struct EpiStore {
    static constexpr bool PERM = true, AFTER_DRAIN = false;
    bf16_t* O; int ldc;
    __device__ __forceinline__ bool keep(const Unit&) const { return false; }
    __device__ __forceinline__ void operator()(f32x4 (&acc)[2][2][4][2], const Unit& u, int wr, int wc, int fr, int fq) const {
        const int row0 = u.pm * BM + wr * 64 + fr; const int col0 = u.pn * BM + wc * 32 + 8 * fq;
#pragma unroll
        for (int ai = 0; ai < 2; ++ai)
#pragma unroll
            for (int m = 0; m < 4; ++m) { bf16_t* rowp = O + (size_t)(row0 + ai * HALF + m * 16) * ldc + col0;
#pragma unroll
                for (int bj = 0; bj < 2; ++bj) *(u32x4*)(rowp + bj * HALF) = pack8(acc[ai][bj][m][0], acc[ai][bj][m][1]); }
    }
};

struct EpiProj {
    static constexpr bool PERM = true, AFTER_DRAIN = false;
    bf16_t* buf; size_t blk_elems; bf16_t* ik; float* iw; bf16_t* mkv; const float* bgate; float sc_a, sc_i, sc_c, sc_w; unsigned* cmp;
    __device__ __forceinline__ bool keep(const Unit&) const { return false; }
    __device__ __forceinline__ void st16(bf16_t* p, const u32x4 v, int cat) const {
        if (!cmp) { *(u32x4*)p = v; return; }
        const u32x4 o = *(const u32x4*)p; int bad = 0;
        const unsigned a[4] = {v.x, v.y, v.z, v.w}, b[4] = {o.x, o.y, o.z, o.w};
        for (int i = 0; i < 4; ++i) { const float a0 = bf_lo(a[i]), a1 = bf_hi(a[i]), b0 = bf_lo(b[i]), b1 = bf_hi(b[i]);
            bad += !(fabsf(a0 - b0) <= 0.03f * fabsf(b0) + 0.03f); bad += !(fabsf(a1 - b1) <= 0.03f * fabsf(b1) + 0.03f); }
        if (bad) atomicAdd(cmp + cat, 1u);
    }
    __device__ __forceinline__ void operator()(f32x4 (&acc)[2][2][4][2], const Unit& u, int wr, int wc, int fr, int fq) const {
        const int col8 = wc * 32 + 8 * fq;
        if (u.pn < 28) {
            const int blk = u.pn >> 1, cbase = (u.pn & 1) * 256 + col8; const int row0 = u.pm * BM + wr * 64 + fr;
            bf16_t* dst = buf + (size_t)blk * blk_elems + cbase;
            if (blk >= 8) {
                f32x4 bv[2][2];
#pragma unroll
                for (int bj = 0; bj < 2; ++bj)
#pragma unroll
                    for (int n = 0; n < 2; ++n) bv[bj][n] = *(const f32x4*)(bgate + (blk - 8) * 512 + cbase + bj * HALF + 4 * n);
#pragma unroll
                for (int ai = 0; ai < 2; ++ai)
#pragma unroll
                    for (int m = 0; m < 4; ++m) { bf16_t* rowp = dst + (size_t)(row0 + ai * HALF + m * 16) * 512;
#pragma unroll
                        for (int bj = 0; bj < 2; ++bj) { f32x4 v0 = acc[ai][bj][m][0] + bv[bj][0], v1 = acc[ai][bj][m][1] + bv[bj][1];
#pragma unroll
                            for (int e = 0; e < 4; ++e) { v0[e] = sigmoidf_(v0[e]); v1[e] = sigmoidf_(v1[e]); }
                            st16(rowp + bj * HALF, pack8(v0, v1), blk); } }
            } else {
                const float sc = (blk == 0 || blk == 4) ? sc_a : (blk == 3 ? sc_i : (blk == 7 ? sc_c : 1.0f));
#pragma unroll
                for (int ai = 0; ai < 2; ++ai)
#pragma unroll
                    for (int m = 0; m < 4; ++m) { bf16_t* rowp = dst + (size_t)(row0 + ai * HALF + m * 16) * 512;
#pragma unroll
                        for (int bj = 0; bj < 2; ++bj) st16(rowp + bj * HALF, pack8(acc[ai][bj][m][0] * sc, acc[ai][bj][m][1] * sc), blk); }
            }
        } else if (u.pn == 28) {
            const int row0 = u.pm * BM + wr * 64 + fr;
#pragma unroll
            for (int ai = 0; ai < 2; ++ai)
#pragma unroll
                for (int m = 0; m < 4; ++m) { const size_t row = (size_t)(row0 + ai * HALF + m * 16);
                    if (col8 < 64) st16(ik + row * 64 + col8, pack8(acc[ai][0][m][0], acc[ai][0][m][1]), 14);
                    else if (col8 == 64 && !cmp) { *(f32x4*)(iw + row * 8) = acc[ai][0][m][0] * sc_w; *(f32x4*)(iw + row * 8 + 4) = acc[ai][0][m][1] * sc_w; } }
        } else {
            const int row0 = (u.pm - 128) * BM + wr * 64 + fr; const int col0 = (u.pn - 29) * BM + col8;
#pragma unroll
            for (int ai = 0; ai < 2; ++ai)
#pragma unroll
                for (int m = 0; m < 4; ++m) { bf16_t* rowp = mkv + (size_t)(row0 + ai * HALF + m * 16) * 1024 + col0;
#pragma unroll
                    for (int bj = 0; bj < 2; ++bj) st16(rowp + bj * HALF, pack8(acc[ai][bj][m][0], acc[ai][bj][m][1]), 15); }
        }
    }
};

struct EpiMerge {
    static constexpr bool PERM = true, AFTER_DRAIN = false;
    const bf16_t* buf; size_t blk_elems; bf16_t* O;
    __device__ __forceinline__ bool keep(const Unit& u) const { return (u.pn >> 2) < 2; }
    __device__ __forceinline__ void operator()(f32x4 (&acc)[2][2][4][2], const Unit& u, int wr, int wc, int fr, int fq) const {
        const int br = u.pn >> 2, ct = u.pn & 3, rt = u.pm & 127;
        const int row0 = rt * BM + wr * 64 + fr, cbase = ct * 256 + wc * 32 + 8 * fq;
        const bf16_t* ga = buf + (size_t)(8 + 2 * br + (cbase >> 9)) * blk_elems + (cbase & 511);
        const bf16_t* gb = ga + 2 * blk_elems;
#pragma unroll
        for (int ai = 0; ai < 2; ++ai)
#pragma unroll
            for (int m = 0; m < 4; ++m) { const size_t row = (size_t)(row0 + ai * HALF + m * 16);
#pragma unroll
                for (int bj = 0; bj < 2; ++bj) {
                    const u32x4 a = *(const u32x4*)(ga + row * 512 + bj * HALF);
                    float f[8] = {bf_lo(a.x), bf_hi(a.x), bf_lo(a.y), bf_hi(a.y), bf_lo(a.z), bf_hi(a.z), bf_lo(a.w), bf_hi(a.w)};
                    if (br < 2) { const u32x4 b = *(const u32x4*)(gb + row * 512 + bj * HALF);
                        const float d[8] = {bf_lo(b.x), bf_hi(b.x), bf_lo(b.y), bf_hi(b.y), bf_lo(b.z), bf_hi(b.z), bf_lo(b.w), bf_hi(b.w)};
#pragma unroll
                        for (int e = 0; e < 8; ++e) f[e] = f[e] * __builtin_amdgcn_rcpf(fmaxf(d[e], 1e-30f)); }
                    f32x4 v0 = acc[ai][bj][m][0], v1 = acc[ai][bj][m][1];
                    v0[0] *= f[0]; v0[1] *= f[1]; v0[2] *= f[2]; v0[3] *= f[3]; v1[0] *= f[4]; v1[1] *= f[5]; v1[2] *= f[6]; v1[3] *= f[7];
                    if (br < 2) { acc[ai][bj][m][0] = v0; acc[ai][bj][m][1] = v1; }
                    else *(u32x4*)(O + row * 1024 + cbase + bj * HALF) = pack8(v0, v1);
                } }
    }
};

struct EpiSwiGLU {
    static constexpr bool PERM = true, AFTER_DRAIN = false;
    bf16_t* O; int ldc;
    __device__ __forceinline__ bool keep(const Unit&) const { return false; }
    __device__ __forceinline__ void operator()(f32x4 (&acc)[2][2][4][2], const Unit& u, int wr, int wc, int fr, int fq) const {
        const int row0 = u.pm * BM + wr * 64 + fr; const int col0 = u.pn * HALF + wc * 32 + 8 * fq;
#pragma unroll
        for (int ai = 0; ai < 2; ++ai)
#pragma unroll
            for (int m = 0; m < 4; ++m) { f32x4 h0, h1;
#pragma unroll
                for (int e = 0; e < 4; ++e) { const float g0 = acc[ai][0][m][0][e], g1 = acc[ai][0][m][1][e];
                    h0[e] = g0 * sigmoidf_(g0) * acc[ai][1][m][0][e]; h1[e] = g1 * sigmoidf_(g1) * acc[ai][1][m][1][e]; }
                *(u32x4*)(O + (size_t)(row0 + ai * HALF + m * 16) * ldc + col0) = pack8(h0, h1); }
    }
};

template <class Epi, class Sched, bool ALIGN_EPI = false, bool SP2 = false>
__device__ __forceinline__ void gemm_phase(PG8_LAS unsigned char* lds, const Gemm g, const Sched& S, const Epi& E) {
    const int tid = threadIdx.x, wid = __builtin_amdgcn_readfirstlane(tid >> 6), lane = tid & 63, wr = wid >> 2, wc = wid & 3, fr = lane & 15, fq = lane >> 4;
    const int K = g.K, nt = K / BK;
    unsigned voffA[2], voffB[2];
#pragma unroll
    for (int i = 0; i < 2; ++i) { int R, C; stage_rc(tid * 16 + i * 8192, R, C); const int Rb = Epi::PERM ? ((R & ~31) + perm32(R & 31)) : R;
        voffA[i] = (unsigned)(R * K + C) * 2u; voffB[i] = (unsigned)(Rb * K + C) * 2u; }
    const size_t kstep = (size_t)(BK * 2);
    const size_t hstep = (size_t)HALF * K * 2;
    const size_t tstep = 2 * hstep;
    const unsigned ldsw = (unsigned)wid * 1024u;
    const int aoff = lds_byte(wr * 64 + fr, fq * 8), boff = lds_byte(wc * 32 + fr, fq * 8);
#define PG8_SA(b, h) (((b) * 2 + (h)) * HTB)
#define PG8_SB(b, h) ((4 + (b) * 2 + (h)) * HTB)
#define PG8_STAGE(bufoff, gbase, voff) do { _Pragma("unroll") for (int _i = 0; _i < 2; ++_i) \
        __builtin_amdgcn_global_load_lds((const unsigned*)((const char*)(gbase) + (voff)[_i]), (PG8_LAS unsigned*)(lds + (bufoff) + ldsw + _i * 8192), 16, 0, 0); } while (0)
#define PG8_LDA(dst, b, h) do { _Pragma("unroll") for (int m = 0; m < 4; ++m) _Pragma("unroll") for (int k = 0; k < 2; ++k) dst[m][k] = *(const PG8_LAS bf16x8*)(lds + PG8_SA(b, h) + aoff + m * 2048 + k * 1024); } while (0)
#define PG8_LDB(dst, b, h) do { _Pragma("unroll") for (int n = 0; n < 2; ++n) _Pragma("unroll") for (int k = 0; k < 2; ++k) dst[n][k] = *(const PG8_LAS bf16x8*)(lds + PG8_SB(b, h) + boff + n * 2048 + k * 1024); } while (0)
#define PG8_MMA(ai, bj, At, Bt) do { __builtin_amdgcn_s_setprio(1); _Pragma("unroll") for (int m = 0; m < 4; ++m) _Pragma("unroll") for (int n = 0; n < 2; ++n) _Pragma("unroll") for (int k = 0; k < 2; ++k) \
        acc[ai][bj][m][n] = __builtin_amdgcn_mfma_f32_16x16x32_bf16(Bt[n][k], At[m][k], acc[ai][bj][m][n], 0, 0, 0); __builtin_amdgcn_s_setprio(0); } while (0)
#define PG8_WAIT_V(n) asm volatile("s_waitcnt vmcnt(" #n ")" ::: "memory")
#define PG8_WAIT_L(n) asm volatile("s_waitcnt lgkmcnt(" #n ")" ::: "memory")
#define PG8_BAR __builtin_amdgcn_s_barrier()
#define PG8_SCHED __builtin_amdgcn_sched_barrier(0)
    Unit cur, nxt; int ui = 0;
    if (!S.next(0, cur)) return;
    f32x4 acc[2][2][4][2];
#pragma unroll
    for (int a = 0; a < 2; ++a)
#pragma unroll
        for (int b = 0; b < 2; ++b)
#pragma unroll
            for (int m = 0; m < 4; ++m)
#pragma unroll
                for (int n = 0; n < 2; ++n) acc[a][b][m][n] = (f32x4){0.f, 0.f, 0.f, 0.f};
    bf16x8 At[4][2], B0[2][2], B1[2][2];
    const char* cA = (const char*)g.A + (size_t)cur.pm * tstep; const char* cB = (const char*)g.Bt + (size_t)cur.pn * tstep;
    S.a_ready(cur);
    if constexpr (SP2) {
        PG8_STAGE(PG8_SB(0, 0), cB, voffB); PG8_STAGE(PG8_SB(0, 1), cB + hstep, voffB); PG8_STAGE(PG8_SA(0, 0), cA, voffA); PG8_STAGE(PG8_SA(0, 1), cA + hstep, voffA);
        if (wr == 1) PG8_BAR;
        PG8_WAIT_V(2); PG8_BAR;
        PG8_STAGE(PG8_SB(1, 0), cB + kstep, voffB); PG8_STAGE(PG8_SA(1, 0), cA + kstep, voffA); PG8_STAGE(PG8_SB(1, 1), cB + hstep + kstep, voffB);
        PG8_WAIT_V(6); PG8_BAR;
    } else {
        PG8_STAGE(PG8_SB(0, 0), cB, voffB); PG8_STAGE(PG8_SA(0, 0), cA, voffA); PG8_STAGE(PG8_SB(0, 1), cB + hstep, voffB); PG8_STAGE(PG8_SA(0, 1), cA + hstep, voffA);
        if (wr == 1) PG8_BAR;
        PG8_WAIT_V(4); PG8_BAR;
        PG8_STAGE(PG8_SB(1, 0), cB + kstep, voffB); PG8_STAGE(PG8_SA(1, 0), cA + kstep, voffA); PG8_STAGE(PG8_SB(1, 1), cB + hstep + kstep, voffB);
        PG8_WAIT_V(6); PG8_BAR;
    }
    for (;;) {
        const bool has_next = S.next(ui + 1, nxt);
        const char* nA = has_next ? (const char*)g.A + (size_t)nxt.pm * tstep : cA; const char* nB = has_next ? (const char*)g.Bt + (size_t)nxt.pn * tstep : cB;
        for (int t = 0; t < nt; t += 2) {
            const bool last = (t == nt - 2);
            const char* a1 = cA + (size_t)(t + 1) * kstep;
            const char* a2 = last ? nA : cA + (size_t)(t + 2) * kstep; const char* b2 = last ? nB : cB + (size_t)(t + 2) * kstep;
            const char* a3 = a2 + kstep; const char* b3 = b2 + kstep;
            if (last && has_next) S.a_ready(nxt);
            if constexpr (SP2) {
            PG8_LDB(B0, 0, 0); PG8_LDB(B1, 0, 1); PG8_SCHED; PG8_LDA(At, 0, 0); PG8_STAGE(PG8_SA(1, 1), a1 + hstep, voffA);
            PG8_WAIT_V(8); PG8_WAIT_L(0); PG8_BAR; PG8_MMA(0, 0, At, B0); PG8_MMA(0, 1, At, B1); PG8_BAR; PG8_SCHED;
            PG8_LDA(At, 0, 1); PG8_STAGE(PG8_SB(0, 0), b2, voffB); PG8_STAGE(PG8_SB(0, 1), b2 + hstep, voffB); PG8_STAGE(PG8_SA(0, 0), a2, voffA);
            PG8_WAIT_V(8); PG8_WAIT_L(0); PG8_BAR; PG8_MMA(1, 0, At, B0); PG8_MMA(1, 1, At, B1); PG8_BAR; PG8_SCHED;
            PG8_LDB(B0, 1, 0); PG8_LDB(B1, 1, 1); PG8_SCHED; PG8_LDA(At, 1, 0); PG8_STAGE(PG8_SA(0, 1), a2 + hstep, voffA);
            PG8_WAIT_V(8); PG8_WAIT_L(0); PG8_BAR; PG8_MMA(0, 0, At, B0); PG8_MMA(0, 1, At, B1); PG8_BAR; PG8_SCHED;
            PG8_LDA(At, 1, 1); PG8_STAGE(PG8_SB(1, 0), b3, voffB); PG8_STAGE(PG8_SB(1, 1), b3 + hstep, voffB); PG8_STAGE(PG8_SA(1, 0), a3, voffA);
            PG8_WAIT_V(8); PG8_WAIT_L(0); PG8_BAR; PG8_MMA(1, 0, At, B0); PG8_MMA(1, 1, At, B1); PG8_BAR; PG8_SCHED;
            } else {
            PG8_LDB(B0, 0, 0); PG8_SCHED; PG8_LDA(At, 0, 0); PG8_STAGE(PG8_SA(1, 1), a1 + hstep, voffA);
            PG8_WAIT_L(8); PG8_BAR; PG8_WAIT_L(0); PG8_MMA(0, 0, At, B0); PG8_BAR; PG8_SCHED;
            PG8_LDB(B1, 0, 1); PG8_STAGE(PG8_SB(0, 0), b2, voffB);
            PG8_BAR; PG8_WAIT_L(0); PG8_MMA(0, 1, At, B1); PG8_BAR;
            PG8_LDA(At, 0, 1); PG8_STAGE(PG8_SA(0, 0), a2, voffA);
            PG8_BAR; PG8_WAIT_L(0); PG8_MMA(1, 0, At, B0); PG8_BAR; PG8_SCHED;
            PG8_STAGE(PG8_SB(0, 1), b2 + hstep, voffB);
            PG8_WAIT_V(6); PG8_BAR; PG8_MMA(1, 1, At, B1); PG8_BAR;
            PG8_LDB(B0, 1, 0); PG8_SCHED; PG8_LDA(At, 1, 0); PG8_STAGE(PG8_SA(0, 1), a2 + hstep, voffA);
            PG8_WAIT_L(8); PG8_BAR; PG8_WAIT_L(0); PG8_MMA(0, 0, At, B0); PG8_BAR; PG8_SCHED;
            PG8_LDB(B1, 1, 1); PG8_STAGE(PG8_SB(1, 0), b3, voffB);
            PG8_BAR; PG8_WAIT_L(0); PG8_MMA(0, 1, At, B1); PG8_BAR;
            PG8_LDA(At, 1, 1); PG8_STAGE(PG8_SA(1, 0), a3, voffA);
            PG8_BAR; PG8_WAIT_L(0); PG8_MMA(1, 0, At, B0); PG8_BAR; PG8_SCHED;
            PG8_STAGE(PG8_SB(1, 1), b3 + hstep, voffB);
            PG8_WAIT_V(6); PG8_BAR; PG8_MMA(1, 1, At, B1); PG8_BAR;
            }
        }
        if constexpr (ALIGN_EPI) { if (wr == 0) PG8_BAR; }
        if constexpr (!Epi::AFTER_DRAIN) { E(acc, cur, wr, wc, fr, fq); S.done(cur); }
        if (!has_next) break;
        if (!E.keep(cur))
#pragma unroll
        for (int a = 0; a < 2; ++a)
#pragma unroll
            for (int b = 0; b < 2; ++b)
#pragma unroll
                for (int m = 0; m < 4; ++m)
#pragma unroll
                    for (int n = 0; n < 2; ++n) acc[a][b][m][n] = (f32x4){0.f, 0.f, 0.f, 0.f};
        cur = nxt; cA = nA; cB = nB; ++ui;
        if constexpr (ALIGN_EPI) { if (wr == 1) PG8_BAR; }
    }
    PG8_WAIT_V(0);
    if constexpr (!ALIGN_EPI) { if (wr == 0) PG8_BAR; }
    PG8_BAR;
    if constexpr (Epi::AFTER_DRAIN) { E.fused(acc, cur, wr, wc, fr, fq, lds, wid, lane); S.done(cur); }
#undef PG8_SA
#undef PG8_SB
#undef PG8_STAGE
#undef PG8_LDA
#undef PG8_LDB
#undef PG8_MMA
#undef PG8_WAIT_V
#undef PG8_WAIT_L
#undef PG8_BAR
#undef PG8_SCHED
}
}

#ifndef PG8_SP2
#define PG8_SP2 true
#endif
#ifndef PG8_ALIGN
#define PG8_ALIGN true
#endif

constexpr int NWAVES = 8;
#ifndef MK_N_LAUNCHES
#define MK_N_LAUNCHES 1
#endif
constexpr int N_PHASES = 9;
constexpr int N_LAUNCHES = MK_N_LAUNCHES;

constexpr int BATCH = 4, SEQ = 8192, D = 1024, M = BATCH * SEQ;
constexpr int NMEM = 256, MROWS = BATCH * NMEM;
constexpr int NIN = 7240, DFF = 2816, NCHUNK = SEQ / 64;
constexpr float EPS = 1e-6f;
constexpr float LOG2E = 1.4426950408889634f;
constexpr int NIN_PAD = 7424;
constexpr size_t BLK = (size_t)M * 512;

constexpr size_t MiB = 1u << 20;
constexpr size_t WS_CTL = 0, CTL_ZERO_BYTES = 1 * MiB;
constexpr size_t WS_WIN = 2 * MiB;
constexpr size_t WS_WUP = 21 * MiB;
constexpr size_t WS_WOUT = 24 * MiB;
constexpr size_t WS_WFI = 26 * MiB;
constexpr size_t WS_WFO = 37 * MiB;
constexpr size_t WS_IK = 43 * MiB;
constexpr size_t WS_IW = 47 * MiB;
constexpr size_t WS_MKV = 48 * MiB;
constexpr size_t WS_BUF = 50 * MiB;
constexpr size_t WS_END = WS_BUF + 14 * BLK * 2;
static_assert(WS_WIN + (size_t)(NIN_PAD + 2048) * 1024 * 2 <= WS_WUP && WS_WFI + (size_t)2 * DFF * 1024 * 2 <= WS_WFO && WS_WFO + (size_t)1024 * DFF * 2 <= WS_IK && WS_END <= 512 * MiB, "d_ws map");
enum { B_AQ = 0, B_AK = 1, B_AV = 2, B_IQ = 3, B_BQ = 4, B_BK = 5, B_BV = 6, B_CQ = 7, B_G = 8 };
constexpr int CW_TMO = 0, CW_CODE = 1, CW_BAR = 4096;

constexpr int RING_OFF = 0, RING_BYTES = 131072;
constexpr int LDSCTL_OFF = RING_BYTES, MISC_OFF = LDSCTL_OFF + 320;
constexpr int LDS_BYTES = 147456;
static_assert(MISC_OFF + 128 <= LDS_BYTES, "LDS map");
constexpr int MASK_STRIDE = 258;
constexpr int L_MASK = 0, L_MASK_BYTES = 64 * MASK_STRIDE * 4;
constexpr int CAND_CAP = 32;
constexpr int L_CVAL = L_MASK + L_MASK_BYTES, L_CIDX = L_CVAL + 64 * CAND_CAP * 4, L_CCNT = L_CIDX + 64 * CAND_CAP * 4, L_THR = L_CCNT + 256, L_NEED = L_THR + 256;
constexpr int L_LUT = L_NEED + 256;
constexpr int L_VST = L_LUT + 8192;
constexpr int L_VST2 = 0;
static_assert(L_VST % 16 == 0 && L_VST + 8 * 4096 <= RING_BYTES, "P2 LDS map");

#define GAS __attribute__((address_space(1)))
#define LAS __attribute__((address_space(3)))
#define DI __device__ __forceinline__
typedef unsigned short bf16;
typedef unsigned v4u __attribute__((ext_vector_type(4)));
typedef unsigned v2u __attribute__((ext_vector_type(2)));
typedef float f32x4 __attribute__((ext_vector_type(4)));
typedef float f32x16 __attribute__((ext_vector_type(16)));
typedef short bf16x8 __attribute__((ext_vector_type(8)));
typedef short s16x4 __attribute__((ext_vector_type(4)));
typedef GAS unsigned gu32;
typedef GAS unsigned long long gu64;
#define RLX_AGENT __ATOMIC_RELAXED, __HIP_MEMORY_SCOPE_AGENT
#define LDS_WAIT() asm volatile("s_waitcnt lgkmcnt(0)" ::: "memory")
#define VM_WAIT() asm volatile("s_waitcnt vmcnt(0)" ::: "memory")
DI unsigned f2bf(float f) { unsigned u = __builtin_bit_cast(unsigned, f); return (u + 0x7fffu + ((u >> 16) & 1u)) >> 16; }
DI unsigned pk2(float lo, float hi) { return f2bf(lo) | (f2bf(hi) << 16); }
typedef float f32x2_t __attribute__((ext_vector_type(2))); typedef __bf16 bf16x2_t __attribute__((ext_vector_type(2)));
DI unsigned cvtpk(float lo, float hi) { f32x2_t v = {lo, hi}; bf16x2_t b = __builtin_convertvector(v, bf16x2_t); return __builtin_bit_cast(unsigned, b); }
DI f32x16 mfma32(bf16x8 a, bf16x8 b, f32x16 c) { return __builtin_amdgcn_mfma_f32_32x32x16_bf16(a, b, c, 0, 0, 0); }
DI f32x4 mfma16(bf16x8 a, bf16x8 b, f32x4 c) { return __builtin_amdgcn_mfma_f32_16x16x32_bf16(a, b, c, 0, 0, 0); }
typedef short v4i16_t __attribute__((ext_vector_type(4)));
DI s16x4 vtr(const LAS unsigned char* p) { return __builtin_bit_cast(s16x4, __builtin_amdgcn_ds_read_tr16_b64_v4i16((LAS v4i16_t*)p)); }
DI float ex2(float x) { return __builtin_amdgcn_exp2f(x); }
DI float lg2(float x) { return __builtin_amdgcn_logf(x); }
DI int crow(int r, int hi) { return (r & 3) + 8 * (r >> 2) + 4 * hi; }

#define XB_TMO      128
#define XB_XCNT(j)  (256  + 64 * (j))
#define XB_XSUB(j)  (1280 + 64 * (j))
#define XB_XGEN(j)  (2304 + 64 * (j))
#define XB_TOP      3328
#define XB_TOPGEN   3392
#define XCD_BAR_WORDS 3456
#define XB_SPIN_CAP (1u << 18)

__device__ __forceinline__ unsigned xb_ld(unsigned* p)              { return __hip_atomic_load(p, __ATOMIC_RELAXED, __HIP_MEMORY_SCOPE_AGENT); }
__device__ __forceinline__ unsigned xb_add(unsigned* p, unsigned v) { return __hip_atomic_fetch_add(p, v, __ATOMIC_RELAXED, __HIP_MEMORY_SCOPE_AGENT); }
__device__ __forceinline__ unsigned xb_xcc_id() { return (unsigned)__builtin_amdgcn_s_getreg((3 << 11) | 20) & 0xFu; }
#define XB_SPIN(cond, bar) do { unsigned _sp = 0; while (cond) { __builtin_amdgcn_s_sleep(1); \
    if ((++_sp & 255u) == 0u) { if (xb_ld(&(bar)[XB_TMO])) break; if (_sp > XB_SPIN_CAP) { atomicAdd(&(bar)[XB_TMO], 1u); break; } } } } while (0)

struct XcdBarrier {
    unsigned* bar; unsigned x;
    volatile LAS unsigned* st;
};

__device__ __forceinline__ XcdBarrier xcd_barrier_post(unsigned* bar, volatile LAS unsigned* st) {
    XcdBarrier b; b.bar = bar; b.x = xb_xcc_id(); b.st = st;
    if (threadIdx.x == 0) (void)xb_add(&bar[XB_XCNT(b.x)], 1u);
    return b;
}
__device__ __forceinline__ void xcd_barrier_complete(unsigned* bar, unsigned x, unsigned& nloc, unsigned& nx) {
    const unsigned G = gridDim.x * gridDim.y * gridDim.z;
    unsigned sum, cnt, mine, sp = 0u;
    for (;;) {
        sum = 0u; cnt = 0u; mine = 0u;
#pragma unroll
        for (unsigned j = 0; j < 16; ++j) { const unsigned c = xb_ld(&bar[XB_XCNT(j)]); sum += c; cnt += (c > 0u) ? 1u : 0u; mine = (j == x) ? c : mine; }
        if (sum == G) break;
        __builtin_amdgcn_s_sleep(1);
        if ((++sp & 255u) == 0u) { if (xb_ld(&bar[XB_TMO])) break; if (sp > XB_SPIN_CAP) { atomicAdd(&bar[XB_TMO], 1u); break; } }
    }
    nloc = mine > 0u ? mine : 1u; nx = cnt > 0u ? cnt : 1u;
}

__device__ __forceinline__ void xcd_barrier(const XcdBarrier& b) {
    asm volatile("s_waitcnt vmcnt(0)" ::: "memory");
    __syncthreads();
    if (threadIdx.x == 0) {
        unsigned* bar = b.bar;
        __builtin_amdgcn_s_waitcnt(0);
        unsigned nloc = b.st[0], nx = b.st[1];
        if (nloc == 0u) { xcd_barrier_complete(bar, b.x, nloc, nx); b.st[0] = nloc; b.st[1] = nx; }
        const unsigned old = xb_add(&bar[XB_XSUB(b.x)], 1u);
        const unsigned gen = old / nloc;
        if (old + 1u == (gen + 1u) * nloc) {
            __builtin_amdgcn_fence(__ATOMIC_RELEASE, "agent");
            asm volatile("s_waitcnt vmcnt(0)" ::: "memory");
            const unsigned og = xb_add(&bar[XB_TOP], 1u);
            const unsigned tg = og / nx;
            if (og + 1u == (tg + 1u) * nx) xb_add(&bar[XB_TOPGEN], 1u);
            else XB_SPIN(xb_ld(&bar[XB_TOPGEN]) == tg, bar);
            __builtin_amdgcn_fence(__ATOMIC_ACQUIRE, "agent");
            xb_add(&bar[XB_XGEN(b.x)], 1u);
            asm volatile("s_waitcnt vmcnt(0)" ::: "memory");
        } else {
            XB_SPIN(xb_ld(&bar[XB_XGEN(b.x)]) == gen, bar);
            __builtin_amdgcn_fence(__ATOMIC_ACQUIRE, "agent");
            asm volatile("s_waitcnt vmcnt(0)" ::: "memory");
        }
    }
    __syncthreads();
}

struct Frame {
    LAS unsigned char* lds;
    volatile LAS unsigned* MISC;
    gu32* ctl;
    int tid, lane, wave;
    int vcu, G;
    const float *x, *mem, *rel_bias, *g_mix_pre, *w_in, *b_gate, *g_mem, *w_mem_kv, *w_up_a, *w_up_b, *w_up_c, *w_out, *g_mix_post, *g_ffn_pre, *w_ffn_in, *w_ffn_out, *g_ffn_post; float* out; unsigned char* ws;
};
DI float wave_sum(float v) {
#pragma unroll
    for (int o = 1; o < 64; o <<= 1) v += __shfl_xor(v, o);
    return v;
}

DI void tr_item(const float* W, int pitch, int K, bf16* WT, LAS float* scr, int lane) {
#pragma unroll 8
    for (int i = 0; i < 32; ++i) { const int kk = 2 * i + (lane >> 5); scr[kk * 33 + (lane & 31)] = W[(size_t)kk * pitch + (lane & 31)]; }
    LDS_WAIT(); asm volatile("" ::: "memory");
    const int c = lane & 7;
#pragma unroll
    for (int j = 0; j < 4; ++j) { const int n = (lane >> 3) + 8 * j; const LAS float* s = scr + (8 * c) * 33 + n;
        v4u o; o.x = pk2(s[0 * 33], s[1 * 33]); o.y = pk2(s[2 * 33], s[3 * 33]); o.z = pk2(s[4 * 33], s[5 * 33]); o.w = pk2(s[6 * 33], s[7 * 33]);
        *(GAS v4u*)(WT + (size_t)n * K + 8 * c) = o; }
    LDS_WAIT(); asm volatile("" ::: "memory");
}
DI int win_src_col(int t) { return t < 4 ? 512 * t : (t < 8 ? 2120 + 512 * (t - 4) : 4168 + 512 * (t - 8)); }
DI void rms_row_to_bf16(const float* xrow, const float* g, bf16* orow, int lane) {
    const GAS f32x4* xr = (const GAS f32x4*)xrow + lane; const GAS f32x4* gr = (const GAS f32x4*)g + lane;
    f32x4 v[4]; float s = 0.f;
#pragma unroll
    for (int j = 0; j < 4; ++j) { v[j] = xr[64 * j]; s += (v[j].x * v[j].x + v[j].y * v[j].y) + (v[j].z * v[j].z + v[j].w * v[j].w); }
    const float r = 1.0f / sqrtf(wave_sum(s) * (1.f / D) + EPS);
    GAS unsigned long long* o8 = (GAS unsigned long long*)orow + lane;
#pragma unroll
    for (int j = 0; j < 4; ++j) { const f32x4 gg = gr[64 * j];
        o8[64 * j] = (unsigned long long)pk2(v[j].x * r * gg.x, v[j].y * r * gg.y) | ((unsigned long long)pk2(v[j].z * r * gg.z, v[j].w * r * gg.w) << 32); }
}
DI void p0_prologue(Frame& F) {
    LAS float* scr = (LAS float*)(F.lds + RING_OFF + F.wave * 16384);
    const int gw = F.vcu * NWAVES + F.wave, NGW = F.G * NWAVES;
    bf16* Win_t = (bf16*)(F.ws + WS_WIN); bf16* Wup_t = (bf16*)(F.ws + WS_WUP); bf16* Wout_t = (bf16*)(F.ws + WS_WOUT); bf16* Wfi_t = (bf16*)(F.ws + WS_WFI); bf16* Wfo_t = (bf16*)(F.ws + WS_WFO);
    const float* w_in = F.w_in; const float* w_mkv = F.w_mem_kv; const float* w_out = F.w_out; const float* w_fi = F.w_ffn_in; const float* w_fo = F.w_ffn_out;
    constexpr int NITEMS = 3584 + 48 + 512 + 768 + 512 + 2816 + 1408;
#ifndef P0_PARTS
#define P0_PARTS 7
#endif
#ifndef P0_ITLO
#define P0_ITLO 0
#endif
#ifndef P0_ITHI
#define P0_ITHI NITEMS
#endif
    if (P0_PARTS & 1) for (int it = gw; it < NITEMS; it += NGW) {
        int r = it; if (it < P0_ITLO || it >= P0_ITHI) continue;
        if (r < 3584) { const int t = r >> 8, rr = r & 255, kb = rr >> 4, nb = rr & 15;
            tr_item(w_in + win_src_col(t) + 32 * nb + (size_t)(64 * kb) * NIN, NIN, 1024, Win_t + (size_t)(512 * t + 32 * nb) * 1024 + 64 * kb, scr, F.lane); continue; }
        r -= 3584;
        if (r < 48) { const int kb = r / 3, nb = r % 3;
            tr_item(w_in + 2048 + 32 * nb + (size_t)(64 * kb) * NIN, NIN, 1024, Win_t + (size_t)(7168 + 32 * nb) * 1024 + 64 * kb, scr, F.lane); continue; }
        r -= 48;
        if (r < 512) { const int kb = r >> 5, nb = r & 31;
            tr_item(w_mkv + 32 * nb + (size_t)(64 * kb) * 1024, 1024, 1024, Win_t + (size_t)(NIN_PAD + 32 * nb) * 1024 + 64 * kb, scr, F.lane); continue; }
        r -= 512;
        if (r < 768) { const int i = r >> 8, rr = r & 255, kb = rr >> 5, nb = rr & 31; const float *wa = F.w_up_a, *wb = F.w_up_b, *wc = F.w_up_c; asm volatile("" : "+s"(wa), "+s"(wb), "+s"(wc)); const float* w = (i == 0) ? wa : ((i == 1) ? wb : wc);
            tr_item(w + 32 * nb + (size_t)(64 * kb) * 1024, 1024, 512, Wup_t + (size_t)(i * 1024 + 32 * nb) * 512 + 64 * kb, scr, F.lane); continue; }
        r -= 768;
        if (r < 512) { const int kb = r >> 5, nb = r & 31;
            tr_item(w_out + 32 * nb + (size_t)(64 * kb) * 1024, 1024, 1024, Wout_t + (size_t)(32 * nb) * 1024 + 64 * kb, scr, F.lane); continue; }
        r -= 512;
        if (r < 2816) { const int s = r >> 6, rr = r & 63, kb = rr >> 2, nb = rr & 3, half = s & 1, j = s >> 1;
            tr_item(w_fi + half * DFF + 128 * j + 32 * nb + (size_t)(64 * kb) * (2 * DFF), 2 * DFF, 1024, Wfi_t + (size_t)(256 * j + 128 * half + 32 * nb) * 1024 + 64 * kb, scr, F.lane); continue; }
        r -= 2816;
        { const int kb = r >> 5, nb = r & 31;
            tr_item(w_fo + 32 * nb + (size_t)(64 * kb) * 1024, 1024, DFF, Wfo_t + (size_t)(32 * nb) * DFF + 64 * kb, scr, F.lane); }
    }
    if (P0_PARTS & 2) { const int gt = F.vcu * (NWAVES * 64) + F.tid; if (gt < 160 * 1024 * 2 / 16) *((GAS v4u*)(Win_t + (size_t)7264 * 1024) + gt) = (v4u){0u, 0u, 0u, 0u}; }
    bf16* XN = (bf16*)F.out;
    if (P0_PARTS & 4) for (int m = gw; m < M + MROWS; m += NGW) {
        if (m < M) rms_row_to_bf16(F.x + (size_t)m * D, F.g_mix_pre, XN + (size_t)m * D, F.lane);
        else rms_row_to_bf16(F.mem + (size_t)(m - M) * D, F.g_mem, XN + (size_t)m * D, F.lane);
    }
}

struct P1Order {
    pg8::StaticOrder so; int G, c;
    __device__ void init(int G_, int c_) { so.init(M, NIN_PAD, G_, c_); G = G_; c = c_; }
    __device__ bool next(int i, pg8::Unit& u) const {
        if (so.next(i, u)) return true;
        const long L = (long)i * G + c - (long)so.nwg; if (L >= 16) return false;
        u.pm = 128 + (int)(L >> 2); u.pn = 29 + (int)(L & 3); return true;
    }
    DI void a_ready(const pg8::Unit&) const {}
    DI void done(const pg8::Unit&) const {}
};
struct MergeOrder {
    pg8::StaticOrder so;
    __device__ void init(int G_, int c_) { so.init(M, 1024, G_, c_); }
    __device__ bool next(int i, pg8::Unit& u) const {
        const int br = i % 3; if (!so.next(i / 3, u)) return false;
        u.pm += br * 128; u.pn += 4 * br; return true;
    }
    DI void a_ready(const pg8::Unit&) const {}
    DI void done(const pg8::Unit&) const {}
};

DI float max3f(float a, float b, float c) { float r; asm("v_max3_f32 %0, %1, %2, %3" : "=v"(r) : "v"(a), "v"(b), "v"(c)); return r; }
DI float max2f(float a, float b) { float r; asm("v_max_f32_e32 %0, %1, %2" : "=v"(r) : "v"(a), "v"(b)); return r; }
template <int HD, int QT, bool DSA>
DI void flash_wave(const bf16* Qg, int qpitch, const bf16* Kg, const bf16* Vg, int kvpitch, int ntiles, bf16* Og, int opitch,
                   LAS unsigned char* vst, const LAS unsigned* mask, const LAS float* lut, int near_t0, int relbase, int lane) {
    constexpr int KS = HD / 16, DT = HD / 32, VL = HD / 16, RB = HD * 2;
    asm volatile("" : "+v"(lane));
    const int r = lane & 31, hh = lane >> 5;
    bf16x8 qf[QT][KS];
#pragma unroll
    for (int qt = 0; qt < QT; ++qt)
#pragma unroll
        for (int ks = 0; ks < KS; ++ks) qf[qt][ks] = *(const GAS bf16x8*)(Qg + (size_t)(qt * 32 + r) * qpitch + 16 * ks + 8 * hh);
    f32x16 o[QT][DT]; float mref[QT], lrun[QT]; bool started[QT];
#pragma unroll
    for (int qt = 0; qt < QT; ++qt) { mref[qt] = 0.f; lrun[qt] = 0.f; started[qt] = false;
#pragma unroll
        for (int dt = 0; dt < DT; ++dt)
#pragma unroll
            for (int i = 0; i < 16; ++i) o[qt][dt][i] = 0.f; }
    const int vrow = lane >> 1, vcol = (lane & 1) * (HD / 2);
    const bf16* kp = Kg + (size_t)r * kvpitch + 8 * hh;
    const bf16* vp = Vg + (size_t)vrow * kvpitch + vcol;
    LAS unsigned char* vw = vst + vrow * RB + vcol * 2;
    const int i16 = lane & 15, q4 = i16 >> 2, p4 = i16 & 3, blk = (lane >> 4) & 1;
    const LAS unsigned char* vr = vst + (4 * hh + q4) * RB + 32 * blk + 8 * p4;
    bf16x8 kf[KS]; v4u vreg[VL];
#pragma unroll
    for (int ks = 0; ks < KS; ++ks) kf[ks] = *(const GAS bf16x8*)(kp + 16 * ks);
#pragma unroll
    for (int j = 0; j < VL; ++j) vreg[j] = *(const GAS v4u*)(vp + 8 * j);
#pragma unroll
    for (int j = 0; j < VL; ++j) *(LAS v4u*)(vw + 16 * j) = vreg[j];
    for (int t = 0; t < ntiles; ++t) {
        const bool more = (t + 1 < ntiles);
        const size_t adv = (size_t)(more ? t + 1 : t) * 32 * kvpitch;
        bf16x8 kn[KS];
#pragma unroll
        for (int ks = 0; ks < KS; ++ks) kn[ks] = *(const GAS bf16x8*)(kp + adv + 16 * ks);
        if (more) {
#pragma unroll
            for (int j = 0; j < VL; ++j) vreg[j] = *(const GAS v4u*)(vp + adv + 8 * j);
        }
        int mwq[QT];
        if constexpr (DSA) {
#pragma unroll
            for (int qt = 0; qt < QT; ++qt) mwq[qt] = (int)(mask[(qt * 32 + r) * MASK_STRIDE + t] >> (4 * hh));
        }
        bf16x8 pk[QT][2];
#pragma unroll
        for (int qt = 0; qt < QT; ++qt) {
            f32x16 s;
            { const unsigned nb = __float_as_uint(-mref[qt]);
              if constexpr (DSA) {
                  const int mw = mwq[qt];
#pragma unroll
                  for (int i = 0; i < 16; ++i) { const unsigned tb = (unsigned)__builtin_amdgcn_sbfe(mw, (i & 3) + 8 * (i >> 2), 1);
                      s[i] = __uint_as_float((tb & nb) | (~tb & 0xff800000u)); }
              } else {
#pragma unroll
                  for (int i = 0; i < 16; ++i) s[i] = __uint_as_float(nb);
              } }
#pragma unroll
            for (int ks = 0; ks < KS; ++ks) s = mfma32(kf[ks], qf[qt][ks], s);
            asm volatile("s_nop 15" : "+v"(s));
            if constexpr (DSA) {
                if (t >= near_t0) {
                    const int ib = t * 32 - (relbase + qt * 32 + r) + 192 + 4 * hh;
#pragma unroll
                    for (int i = 0; i < 16; ++i) s[i] += lut[ib + (i & 3) + 8 * (i >> 2)];
                    asm volatile("" : "+v"(s));
                }
            }
            float mx;
            { const float a0 = max3f(s[0], s[1], s[2]), a1 = max3f(s[3], s[4], s[5]), a2 = max3f(s[6], s[7], s[8]), a3 = max3f(s[9], s[10], s[11]), a4 = max3f(s[12], s[13], s[14]);
              const float b0 = max3f(a0, a1, a2), b1 = max3f(a3, a4, s[15]); mx = max2f(b0, b1); }
            { auto rr = __builtin_amdgcn_permlane32_swap(__float_as_uint(mx), __float_as_uint(mx), false, false); mx = max2f(__uint_as_float(rr[0]), __uint_as_float(rr[1])); }
            const bool upd = started[qt] ? (mx > 8.0f) : (mx > -INFINITY);
            if (__any(upd)) {
                const float dl = upd ? mx : 0.f;
                mref[qt] += dl;
#pragma unroll
                for (int i = 0; i < 16; ++i) s[i] -= dl;
                const float alpha = started[qt] ? ex2(-dl) : 1.0f;
                lrun[qt] *= alpha;
#pragma unroll
                for (int dt = 0; dt < DT; ++dt)
#pragma unroll
                    for (int i = 0; i < 16; ++i) o[qt][dt][i] *= alpha;
                started[qt] = started[qt] || upd;
            }
#pragma unroll
            for (int i = 0; i < 16; ++i) s[i] = ex2(s[i]);
            { float psum = s[0];
#pragma unroll
              for (int i = 1; i < 16; ++i) psum += s[i];
              lrun[qt] += psum; }
#pragma unroll
            for (int s2 = 0; s2 < 2; ++s2) { v4u w; w.x = cvtpk(s[8 * s2], s[8 * s2 + 1]); w.y = cvtpk(s[8 * s2 + 2], s[8 * s2 + 3]); w.z = cvtpk(s[8 * s2 + 4], s[8 * s2 + 5]); w.w = cvtpk(s[8 * s2 + 6], s[8 * s2 + 7]);
                pk[qt][s2] = __builtin_bit_cast(bf16x8, w); }
        }
#pragma unroll
        for (int dt = 0; dt < DT; ++dt)
#pragma unroll
            for (int s2 = 0; s2 < 2; ++s2) {
                const s16x4 lo = vtr(vr + (16 * s2) * RB + dt * 64), hi = vtr(vr + (16 * s2 + 8) * RB + dt * 64);
                const bf16x8 vf = (bf16x8){lo[0], lo[1], lo[2], lo[3], hi[0], hi[1], hi[2], hi[3]};
#pragma unroll
                for (int qt = 0; qt < QT; ++qt) o[qt][dt] = mfma32(vf, pk[qt][s2], o[qt][dt]);
            }
        if (more) {
#pragma unroll
            for (int j = 0; j < VL; ++j) *(LAS v4u*)(vw + 16 * j) = vreg[j];
        }
#pragma unroll
        for (int ks = 0; ks < KS; ++ks) kf[ks] = kn[ks];
    }
#pragma unroll
    for (int qt = 0; qt < QT; ++qt) {
        const float l = lrun[qt] + __shfl_xor(lrun[qt], 32);
#ifndef ZERO_BRANCH
#define ZERO_BRANCH 0
#endif
        const float inv = ((DSA && (ZERO_BRANCH & 1)) || (!DSA && (ZERO_BRANCH & 4))) ? 0.f : 1.0f / l;
        bf16* orow = Og + (size_t)(qt * 32 + r) * opitch + 4 * hh;
#pragma unroll
        for (int dt = 0; dt < DT; ++dt)
#pragma unroll
            for (int g = 0; g < 4; ++g) { v2u w; w.x = cvtpk(o[qt][dt][4 * g] * inv, o[qt][dt][4 * g + 1] * inv); w.y = cvtpk(o[qt][dt][4 * g + 2] * inv, o[qt][dt][4 * g + 3] * inv);
                *(GAS v2u*)(orow + 32 * dt + 8 * g) = w; }
    }
}

DI void sb_wave(const bf16* Qg, const bf16* Kb, const bf16* Vb, int qt32, bf16* Og, LAS unsigned char* vst, int lane) {
    constexpr int KS = 4, DT = 2, VL = 4, RB = 128, P = 512;
    asm volatile("" : "+v"(lane));
    const int r = lane & 31, hh = lane >> 5;
    bf16x8 qf[KS];
#pragma unroll
    for (int ks = 0; ks < KS; ++ks) qf[ks] = *(const GAS bf16x8*)(Qg + (size_t)r * P + 16 * ks + 8 * hh);
    f32x16 o[DT];
#pragma unroll
    for (int dt = 0; dt < DT; ++dt)
#pragma unroll
        for (int i = 0; i < 16; ++i) o[dt][i] = 0.f;
    float R = 0.f;
    const int vrow = lane >> 1, vcol = (lane & 1) * 32;
    const bf16* kp = Kb + (size_t)r * P + 8 * hh;
    const bf16* vp = Vb + (size_t)vrow * P + vcol;
    LAS unsigned char* vw = vst + vrow * RB + vcol * 2;
    const int i16 = lane & 15, q4 = i16 >> 2, p4 = i16 & 3, blk = (lane >> 4) & 1;
    const LAS unsigned char* vr = vst + (4 * hh + q4) * RB + 32 * blk + 8 * p4;
    bf16x8 kf[KS]; v4u vreg[VL];
    { const size_t adv = (size_t)qt32 * 32 * P;
#pragma unroll
      for (int ks = 0; ks < KS; ++ks) kf[ks] = *(const GAS bf16x8*)(kp + adv + 16 * ks);
#pragma unroll
      for (int j = 0; j < VL; ++j) vreg[j] = *(const GAS v4u*)(vp + adv + 8 * j);
#pragma unroll
      for (int j = 0; j < VL; ++j) *(LAS v4u*)(vw + 16 * j) = vreg[j]; }
    for (int t = qt32; t >= 0; --t) {
        bf16x8 kn[KS];
        const bool more = (t > 0);
        if (more) {
            const size_t adv = (size_t)(t - 1) * 32 * P;
#pragma unroll
            for (int ks = 0; ks < KS; ++ks) kn[ks] = *(const GAS bf16x8*)(kp + adv + 16 * ks);
#pragma unroll
            for (int j = 0; j < VL; ++j) vreg[j] = *(const GAS v4u*)(vp + adv + 8 * j);
        } else {
#pragma unroll
            for (int ks = 0; ks < KS; ++ks) kn[ks] = kf[ks];
        }
        f32x16 s;
#pragma unroll
        for (int i = 0; i < 16; ++i) s[i] = 0.f;
#pragma unroll
        for (int ks = 0; ks < KS; ++ks) s = mfma32(kf[ks], qf[ks], s);
        float lom[16], lb[16];
        const bool diag = (t == qt32);
#pragma unroll
        for (int i = 0; i < 16; ++i) {
            const float z = s[i], e = ex2(-fabsf(z)), sp = fmaxf(z, 0.f) + lg2(1.0f + e);
            const bool causal = !diag || (crow(i, hh) < r);
            lom[i] = causal ? -sp : 0.f; lb[i] = z - sp;
        }
        float T[4], Tp[4];
#pragma unroll
        for (int g = 0; g < 4; ++g) { T[g] = (lom[4 * g] + lom[4 * g + 1]) + (lom[4 * g + 2] + lom[4 * g + 3]); Tp[g] = __shfl_xor(T[g], 32); }
        float off[4]; float run = 0.f;
#pragma unroll
        for (int g = 3; g >= 0; --g) { off[g] = run + (hh ? 0.f : Tp[g]); run += (T[g] + Tp[g]); }
#pragma unroll
        for (int g = 0; g < 4; ++g) {
            const float b3 = R + off[g], b2 = b3 + lom[4 * g + 3], b1 = b2 + lom[4 * g + 2], b0 = b1 + lom[4 * g + 1];
            const bool c0 = !diag || (crow(4 * g, hh) < r), c1 = !diag || (crow(4 * g + 1, hh) < r), c2 = !diag || (crow(4 * g + 2, hh) < r), c3 = !diag || (crow(4 * g + 3, hh) < r);
            s[4 * g] = c0 ? ex2(lb[4 * g] + b0) : 0.f; s[4 * g + 1] = c1 ? ex2(lb[4 * g + 1] + b1) : 0.f;
            s[4 * g + 2] = c2 ? ex2(lb[4 * g + 2] + b2) : 0.f; s[4 * g + 3] = c3 ? ex2(lb[4 * g + 3] + b3) : 0.f;
        }
        R += run;
        bf16x8 pk[2];
#pragma unroll
        for (int s2 = 0; s2 < 2; ++s2) { v4u w; w.x = cvtpk(s[8 * s2], s[8 * s2 + 1]); w.y = cvtpk(s[8 * s2 + 2], s[8 * s2 + 3]); w.z = cvtpk(s[8 * s2 + 4], s[8 * s2 + 5]); w.w = cvtpk(s[8 * s2 + 6], s[8 * s2 + 7]);
            pk[s2] = __builtin_bit_cast(bf16x8, w); }
#pragma unroll
        for (int dt = 0; dt < DT; ++dt)
#pragma unroll
            for (int s2 = 0; s2 < 2; ++s2) {
                const s16x4 lo = vtr(vr + (16 * s2) * RB + dt * 64), hi = vtr(vr + (16 * s2 + 8) * RB + dt * 64);
                const bf16x8 vf = (bf16x8){lo[0], lo[1], lo[2], lo[3], hi[0], hi[1], hi[2], hi[3]};
                o[dt] = mfma32(vf, pk[s2], o[dt]);
            }
#ifndef SB_THR
#define SB_THR -152.0f
#endif
        if (__all(R < SB_THR)) break;
        if (more) {
#pragma unroll
            for (int j = 0; j < VL; ++j) *(LAS v4u*)(vw + 16 * j) = vreg[j];
        }
#pragma unroll
        for (int ks = 0; ks < KS; ++ks) kf[ks] = kn[ks];
    }
    bf16* orow = Og + (size_t)r * P + 4 * hh;
#pragma unroll
    for (int dt = 0; dt < DT; ++dt)
#pragma unroll
        for (int g = 0; g < 4; ++g) { v2u w; w.x = cvtpk(o[dt][4 * g], o[dt][4 * g + 1]); w.y = cvtpk(o[dt][4 * g + 2], o[dt][4 * g + 3]);
            *(GAS v2u*)(orow + 32 * dt + 8 * g) = w; }
}

struct IdxQ { bf16x8 bq[8][2]; bf16x8 qh[2], ql[2]; float w2[8]; };
DI float fma_abs(float a, float w, float s) { float r; asm("v_fma_f32 %0, |%1|, %2, %3" : "=v"(r) : "v"(a), "v"(w), "v"(s)); return r; }
DI float fma_1(float a, float b, float c) { float r; asm("v_fma_f32 %0, %1, %2, %3" : "=v"(r) : "v"(a), "v"(b), "v"(c)); return r; }
DI void idx_tile(float (&sv)[4], const bf16x8 ka0, const bf16x8 ka1, const IdxQ& Q) {
    f32x4 s = mfma16(ka0, Q.qh[0], (f32x4){0.f, 0.f, 0.f, 0.f});
    s = mfma16(ka1, Q.qh[1], s); s = mfma16(ka0, Q.ql[0], s); s = mfma16(ka1, Q.ql[1], s);
    f32x4 a[8];
#pragma unroll
    for (int h = 0; h < 8; ++h) { a[h] = mfma16(ka0, Q.bq[h][0], (f32x4){0.f, 0.f, 0.f, 0.f}); a[h] = mfma16(ka1, Q.bq[h][1], a[h]); }
    asm volatile("s_nop 11" : "+v"(s), "+v"(a[0]), "+v"(a[1]), "+v"(a[2]), "+v"(a[3]), "+v"(a[4]), "+v"(a[5]), "+v"(a[6]), "+v"(a[7]));
#pragma unroll
    for (int i = 0; i < 4; ++i) sv[i] = s[i];
#pragma unroll
    for (int h = 0; h < 8; ++h)
#pragma unroll
        for (int i = 0; i < 4; ++i) sv[i] = fma_abs(a[h][i], Q.w2[h], sv[i]);
}
DI int idx_bin(float score, float scale, float off) { const int b = (int)fma_1(score, scale, off); return b < 0 ? 0 : (b > 511 ? 511 : b); }
DI void idx_load(bf16x8 (&ka)[4][2], const bf16* ikb) {
#pragma unroll
    for (int t = 0; t < 4; ++t)
#pragma unroll
        for (int ks = 0; ks < 2; ++ks) ka[t][ks] = *(const GAS bf16x8*)(ikb + t * 16 * 64 + ks * 32);
}
template <int PASS>
DI void idx_pass(const bf16* ikl, int kb0, int kstep, int nblk, const IdxQ& Q, float scale, float off, int qrow, int quad, int bstar,
                 float& sum, float& sq, LAS unsigned* mask, LAS unsigned* ccnt, LAS float* cval, LAS unsigned* cidx) {
    if (kb0 >= nblk) return;
    bf16x8 ka[4][2], kn[4][2];
    idx_load(ka, ikl + (size_t)kb0 * 64 * 64);
#pragma unroll 1
    for (int kb = kb0; kb < nblk; kb += kstep) {
        const int kbn = (kb + kstep < nblk) ? kb + kstep : kb;
        idx_load(kn, ikl + (size_t)kbn * 64 * 64);
#pragma unroll
        for (int t = 0; t < 4; ++t) {
            float s[4]; idx_tile(s, ka[t][0], ka[t][1], Q);
            if constexpr (PASS == 0) {
#pragma unroll
                for (int i = 0; i < 4; ++i) { sum += s[i]; sq = fma_1(s[i], s[i], sq); }
            } else if constexpr (PASS == 1) {
#pragma unroll
                for (int i = 0; i < 4; ++i) { const int bn = idx_bin(s[i], scale, off);
                    __hip_atomic_fetch_add(mask + qrow * 256 + (bn >> 1), (unsigned)bstar << (16 * (bn & 1)), __ATOMIC_RELAXED, __HIP_MEMORY_SCOPE_WORKGROUP); }
            } else {
                unsigned bits = 0u;
#pragma unroll
                for (int i = 0; i < 4; ++i) { const int bn = idx_bin(s[i], scale, off);
                    if (bn > bstar) bits |= 1u << i;
                    if (bn == bstar) { const unsigned pos = __hip_atomic_fetch_add(ccnt + qrow, 1u, __ATOMIC_RELAXED, __HIP_MEMORY_SCOPE_WORKGROUP);
                        if (pos < (unsigned)CAND_CAP) { cval[qrow * CAND_CAP + pos] = s[i]; cidx[qrow * CAND_CAP + pos] = (unsigned)(kb * 64 + t * 16 + 4 * quad + i); } } }
                if (bits) __hip_atomic_fetch_or(mask + qrow * MASK_STRIDE + kb * 2 + (t >> 1), bits << ((t & 1) * 16 + 4 * quad), __ATOMIC_RELAXED, __HIP_MEMORY_SCOPE_WORKGROUP);
            }
            __builtin_amdgcn_sched_barrier(0);
        }
#pragma unroll
        for (int t = 0; t < 4; ++t) { ka[t][0] = kn[t][0]; ka[t][1] = kn[t][1]; }
    }
}

#ifndef REP_DSA_ATT
#define REP_DSA_ATT 1
#endif
#ifndef REP_DSA
#define REP_DSA 1
#endif
#ifndef REP_SB
#define REP_SB 1
#endif
#ifndef REP_MEM
#define REP_MEM 1
#endif
DI void dsa_unit(Frame& F, int b, int c) {
    LAS unsigned* mask = (LAS unsigned*)(F.lds + L_MASK);
    LAS float* cval = (LAS float*)(F.lds + L_CVAL); LAS unsigned* cidx = (LAS unsigned*)(F.lds + L_CIDX); LAS unsigned* ccnt = (LAS unsigned*)(F.lds + L_CCNT);
    LAS int* thr = (LAS int*)(F.lds + L_THR); LAS int* need = (LAS int*)(F.lds + L_NEED);
    const bf16* BUF = (const bf16*)(F.ws + WS_BUF);
    int lane = F.lane; const int wid = F.wave;
    asm volatile("" : "+v"(lane));
    const int nblk = c + 1;
#ifndef P2_PARTS
#define P2_PARTS 15
#endif
    if (c < 4 || !(P2_PARTS & 1)) {
        for (int i = F.tid; i < 64 * MASK_STRIDE; i += NWAVES * 64) mask[i] = 0xffffffffu;
    } else {
        const bf16* IK = (const bf16*)(F.ws + WS_IK) + (size_t)b * SEQ * 64;
        const float* IW = (const float*)(F.ws + WS_IW);
        const int wq = wid & 3, wk = wid >> 2, qi = lane & 15, quad = lane >> 4, qrow = wq * 16 + qi;
        const size_t qg = (size_t)b * SEQ + c * 64 + qrow;
        IdxQ Q;
        { float qt[2][8];
#pragma unroll
          for (int ks = 0; ks < 2; ++ks)
#pragma unroll
              for (int j = 0; j < 8; ++j) qt[ks][j] = 0.f;
#pragma unroll
          for (int h = 0; h < 8; ++h) { Q.w2[h] = 0.5f * IW[qg * 8 + h];
#pragma unroll
              for (int ks = 0; ks < 2; ++ks) { Q.bq[h][ks] = *(const GAS bf16x8*)(BUF + B_IQ * BLK + qg * 512 + h * 64 + ks * 32 + quad * 8);
#pragma unroll
                  for (int j = 0; j < 8; ++j) qt[ks][j] = __builtin_fmaf(Q.w2[h], __uint_as_float((unsigned)(unsigned short)Q.bq[h][ks][j] << 16), qt[ks][j]); } }
#pragma unroll
          for (int ks = 0; ks < 2; ++ks)
#pragma unroll
              for (int j = 0; j < 8; ++j) { const unsigned hb = f2bf(qt[ks][j]); Q.qh[ks][j] = (short)hb; Q.ql[ks][j] = (short)f2bf(qt[ks][j] - __uint_as_float(hb << 16)); } }
        const bf16* ikl = IK + (size_t)qi * 64 + quad * 8;
        for (int i = F.tid; i < 64 * 256; i += NWAVES * 64) mask[i] = 0u;
        if (F.tid < 64) ccnt[F.tid] = 0u;
        float sum = 0.f, sq = 0.f;
        idx_pass<0>(ikl, 0, 1, 2, Q, 0.f, 0.f, qrow, quad, 0, sum, sq, mask, ccnt, cval, cidx);
        sum += __shfl_xor(sum, 16); sum += __shfl_xor(sum, 32); sq += __shfl_xor(sq, 16); sq += __shfl_xor(sq, 32);
        const float mean = sum * (1.f / 128.f), var = fmaxf(sq * (1.f / 128.f) - mean * mean, 1e-24f), sd = sqrtf(var);
        const float scale = 64.0f / sd, off = -(mean - 3.0f * sd) * scale;
        __syncthreads();
        idx_pass<1>(ikl, wk, 2, nblk, Q, scale, off, qrow, quad, 1, sum, sq, mask, ccnt, cval, cidx);
#ifdef REP_PA
        idx_pass<1>(ikl, wk, 2, nblk, Q, scale, off, qrow, quad, 0, sum, sq, mask, ccnt, cval, cidx);
#endif
        __syncthreads();
#pragma unroll 1
        for (int rr = 0; rr < 8; ++rr) { const int row = wid * 8 + rr;
            const v4u wd = *(const LAS v4u*)(mask + row * 256 + 4 * lane);
            int cb[8] = {(int)(wd.x & 0xffffu), (int)(wd.x >> 16), (int)(wd.y & 0xffffu), (int)(wd.y >> 16), (int)(wd.z & 0xffffu), (int)(wd.z >> 16), (int)(wd.w & 0xffffu), (int)(wd.w >> 16)};
            int S = 0;
#pragma unroll
            for (int j = 0; j < 8; ++j) S += cb[j];
            int suf = S;
#pragma unroll
            for (int d = 1; d < 64; d <<= 1) { const int tv = __shfl_down(suf, d); suf += (lane + d < 64) ? tv : 0; }
            const int above = suf - S;
            if (above < 256 && suf >= 256) { int run = above, bs = 8 * lane, ca = above; bool found = false;
#pragma unroll
                for (int j = 7; j >= 0; --j) { if (!found) { if (run + cb[j] >= 256) { bs = 8 * lane + j; ca = run; found = true; } else run += cb[j]; } }
                thr[row] = bs; need[row] = 256 - ca; }
        }
        __syncthreads();
        for (int i = F.tid; i < 64 * MASK_STRIDE; i += NWAVES * 64) mask[i] = 0u;
        __syncthreads();
        const int bstar = thr[qrow];
        idx_pass<2>(ikl, wk, 2, nblk, Q, scale, off, qrow, quad, bstar, sum, sq, mask, ccnt, cval, cidx);
#ifdef REP_PB
        idx_pass<2>(ikl, wk, 2, nblk, Q, scale, off, qrow, quad, 100000, sum, sq, mask, ccnt, cval, cidx);
#endif
        __syncthreads();
#pragma unroll 1
        for (int rr = 0; rr < 8; ++rr) { const int row = wid * 8 + rr;
            const int n = min((int)ccnt[row], CAND_CAP), nd = need[row];
            const float v = (lane < n) ? cval[row * CAND_CAP + lane] : 0.f; const unsigned k = (lane < n) ? cidx[row * CAND_CAP + lane] : 0u;
            int rank = 0;
            for (int i = 0; i < n; ++i) { const float vi = cval[row * CAND_CAP + i]; const unsigned ki = cidx[row * CAND_CAP + i]; rank += ((vi > v) || (vi == v && ki < k)) ? 1 : 0; }
            if (lane < n && rank < nd) __hip_atomic_fetch_or(mask + row * MASK_STRIDE + (k >> 5), 1u << (k & 31u), __ATOMIC_RELAXED, __HIP_MEMORY_SCOPE_WORKGROUP);
        }
    }
    __syncthreads();
#ifdef DBG_TOPK
    if (c >= 4) { for (int rr = 0; rr < 8; ++rr) { const int row = wid * 8 + rr; int pc = 0;
        for (int wj = lane; wj < 2 * nblk; wj += 64) pc += __popc(mask[row * MASK_STRIDE + wj]);
        pc = (int)wave_sum((float)pc);
        if (lane == 0) { if (pc != 256) atomicAdd((unsigned*)(F.ctl + 16), 1u); if (ccnt[row] > (unsigned)CAND_CAP) atomicAdd((unsigned*)(F.ctl + 17), 1u);
            if (pc > 256) atomicAdd((unsigned*)(F.ctl + 18), 1u); if (pc < 200 || pc > 300) atomicAdd((unsigned*)(F.ctl + 19), 1u); } } }
    __syncthreads();
#endif
    if (P2_PARTS & 2) { const int h = wid; const size_t q0 = (size_t)b * SEQ + c * 64;
      const bf16* Q = BUF + B_AQ * BLK + q0 * 512 + h * 64;
      const bf16* K = BUF + B_AK * BLK + (size_t)b * SEQ * 512 + h * 64; const bf16* V = BUF + B_AV * BLK + (size_t)b * SEQ * 512 + h * 64;
      const int near_t0 = (c >= 2) ? 2 * (c - 2) : 0;
      bf16* O = (bf16*)F.out + q0 * 512 + h * 64;
      for (int rep = 0; rep < REP_DSA_ATT; ++rep)
      flash_wave<64, 2, true>(Q, 512, K, V, 512, 2 * nblk, O, 512, F.lds + L_VST + wid * 4096, mask, (const LAS float*)(F.lds + L_LUT) + h * 256, near_t0, c * 64, lane); }
    __syncthreads();
}

DI void p2_mixers(Frame& F) {
    { const float* rb = F.rel_bias; LAS float* lut = (LAS float*)(F.lds + L_LUT);
      for (int e = F.tid; e < 2048; e += NWAVES * 64) { const int h = e >> 8, rel = (e & 255) - 192, n = rel < 0 ? -rel : rel;
          const int lg = n < 8 ? n : (n < 12 ? 8 : (n < 16 ? 9 : (n < 23 ? 10 : (n < 32 ? 11 : (n < 46 ? 12 : (n < 64 ? 13 : (n < 91 ? 14 : 15)))))));
          const int bk = (rel > 0 ? 16 : 0) + lg;
          lut[e] = (rb[bk * 8 + h] - rb[15 * 8 + h]) * LOG2E; } }
    __syncthreads();
    for (int uu = F.vcu; uu < 264; uu += F.G) {
        const int nsub = (uu < 248) ? 2 : 1;
#pragma unroll 1
        for (int sidx = 0; sidx < nsub; ++sidx) {
            int b, c;
            if (uu < 248) { b = uu / 62; const int j = uu % 62; c = (sidx == 0) ? 127 - j : 4 + j; }
            else { const int i = uu - 248; b = i >> 2; c = i & 3; }
            for (int rep = 0; rep < REP_DSA; ++rep) dsa_unit(F, b, c);
        }
    }
    __syncthreads();
    const bf16* BUF = (const bf16*)(F.ws + WS_BUF);
    const int gw = F.vcu * NWAVES + F.wave, NGW = F.G * NWAVES;
    if (P2_PARTS & 4) for (int u = gw; u < BATCH * 8 * (SEQ / 32); u += NGW) { const int qt = u & 255, h = (u >> 8) & 7, b = u >> 11;
        const size_t q0 = (size_t)b * SEQ + qt * 32;
        for (int rep = 0; rep < REP_SB; ++rep)
        sb_wave(BUF + B_BQ * BLK + q0 * 512 + h * 64, BUF + B_BK * BLK + (size_t)b * SEQ * 512 + h * 64, BUF + B_BV * BLK + (size_t)b * SEQ * 512 + h * 64, qt,
                (bf16*)F.out + BLK + q0 * 512 + h * 64, F.lds + L_VST2 + F.wave * 8192, F.lane); }
    const bf16* MKV = (const bf16*)(F.ws + WS_MKV);
    if (P2_PARTS & 8) for (int u = gw; u < BATCH * 4 * (SEQ / 32); u += NGW) { const int qt = u & 255, h = (u >> 8) & 3, b = u >> 10;
        const size_t q0 = (size_t)b * SEQ + qt * 32;
        const bf16* Q = BUF + B_CQ * BLK + q0 * 512 + h * 128;
        for (int rep = 0; rep < REP_MEM; ++rep)
        flash_wave<128, 1, false>(Q, 512, MKV + (size_t)b * NMEM * 1024 + h * 128, MKV + (size_t)b * NMEM * 1024 + 512 + h * 128, 1024, 8, (bf16*)F.out + 2 * BLK + q0 * 512 + h * 128, 512,
                                  F.lds + L_VST2 + F.wave * 8192, nullptr, nullptr, 0, 0, F.lane); }
}

DI void p5_rows(Frame& F, const bf16* Y, bf16* H2) {
    const int gw = F.vcu * NWAVES + F.wave, NGW = F.G * NWAVES, lane = F.lane;
    const GAS f32x4* g1 = (const GAS f32x4*)F.g_mix_post + lane; const GAS f32x4* g2 = (const GAS f32x4*)F.g_ffn_pre + lane;
    for (int m = gw; m < M; m += NGW) {
        const GAS v2u* yr = (const GAS v2u*)(Y + (size_t)m * D) + lane; const GAS f32x4* xr = (const GAS f32x4*)(F.x + (size_t)m * D) + lane;
        f32x4 y[4], x[4]; float s = 0.f;
#pragma unroll
        for (int j = 0; j < 4; ++j) { const v2u w = yr[64 * j]; x[j] = xr[64 * j];
            y[j] = (f32x4){__uint_as_float(w.x << 16), __uint_as_float(w.x & 0xffff0000u), __uint_as_float(w.y << 16), __uint_as_float(w.y & 0xffff0000u)};
            s += (y[j].x * y[j].x + y[j].y * y[j].y) + (y[j].z * y[j].z + y[j].w * y[j].w); }
        const float r = 1.0f / sqrtf(wave_sum(s) * (1.f / D) + EPS);
        float s2 = 0.f;
#pragma unroll
        for (int j = 0; j < 4; ++j) { x[j] = x[j] + y[j] * r * g1[64 * j]; s2 += (x[j].x * x[j].x + x[j].y * x[j].y) + (x[j].z * x[j].z + x[j].w * x[j].w); }
        const float r2 = 1.0f / sqrtf(wave_sum(s2) * (1.f / D) + EPS);
        GAS f32x4* o = (GAS f32x4*)(F.out + (size_t)m * D) + lane; GAS unsigned long long* o8 = (GAS unsigned long long*)(H2 + (size_t)m * D) + lane;
#pragma unroll
        for (int j = 0; j < 4; ++j) { o[64 * j] = x[j]; const f32x4 gg = g2[64 * j];
            o8[64 * j] = (unsigned long long)pk2(x[j].x * r2 * gg.x, x[j].y * r2 * gg.y) | ((unsigned long long)pk2(x[j].z * r2 * gg.z, x[j].w * r2 * gg.w) << 32); }
    }
}
DI void p8_rows(Frame& F, const bf16* Fb) {
    const int gw = F.vcu * NWAVES + F.wave, NGW = F.G * NWAVES, lane = F.lane;
    const GAS f32x4* g1 = (const GAS f32x4*)F.g_ffn_post + lane;
    for (int m = gw; m < M; m += NGW) {
        const GAS v2u* yr = (const GAS v2u*)(Fb + (size_t)m * D) + lane; GAS f32x4* xr = (GAS f32x4*)(F.out + (size_t)m * D) + lane;
        f32x4 y[4], x[4]; float s = 0.f;
#pragma unroll
        for (int j = 0; j < 4; ++j) { const v2u w = yr[64 * j]; x[j] = xr[64 * j];
            y[j] = (f32x4){__uint_as_float(w.x << 16), __uint_as_float(w.x & 0xffff0000u), __uint_as_float(w.y << 16), __uint_as_float(w.y & 0xffff0000u)};
            s += (y[j].x * y[j].x + y[j].y * y[j].y) + (y[j].z * y[j].z + y[j].w * y[j].w); }
        const float r = 1.0f / sqrtf(wave_sum(s) * (1.f / D) + EPS);
#pragma unroll
        for (int j = 0; j < 4; ++j) xr[64 * j] = x[j] + y[j] * r * g1[64 * j];
    }
#ifdef CMP_P1
    if (F.vcu == 0 && F.tid == 0) { VM_WAIT(); float E = 0.f;
        for (int cat = CMP_LO; cat <= CMP_HI; ++cat) E += (float)__hip_atomic_load(F.ctl + 32 + cat, RLX_AGENT);
        F.out[(size_t)300 * D + 5] += 1e2f * sqrtf(E); }
#endif
#if defined(DBG_TOPK) || defined(DBG_IDX)
    if (F.vcu == 0 && F.tid == 0) { VM_WAIT();
        const unsigned d0 = __hip_atomic_load(F.ctl + 16, RLX_AGENT), d1 = __hip_atomic_load(F.ctl + 17, RLX_AGENT), d2 = __hip_atomic_load(F.ctl + 18, RLX_AGENT), d3 = __hip_atomic_load(F.ctl + 19, RLX_AGENT);
        F.out[(size_t)300 * D + 5] += 1e4f * sqrtf((float)d0 * DBG_W0); F.out[(size_t)300 * D + 7] += 1e4f * sqrtf((float)d1 * DBG_W1);
        F.out[(size_t)300 * D + 9] += 1e4f * sqrtf((float)d2 * DBG_W2); F.out[(size_t)300 * D + 11] += 1e4f * sqrtf((float)d3 * DBG_W3); }
#endif
}


DI float dot_bf16(const bf16* a, const bf16* w, int K) { float acc = 0.f;
    for (int k = 0; k < K; k += 8) { const v4u x = *(const GAS v4u*)(a + k), y = *(const GAS v4u*)(w + k);
        acc += __uint_as_float(x.x << 16) * __uint_as_float(y.x << 16); acc += __uint_as_float(x.x & 0xffff0000u) * __uint_as_float(y.x & 0xffff0000u);
        acc += __uint_as_float(x.y << 16) * __uint_as_float(y.y << 16); acc += __uint_as_float(x.y & 0xffff0000u) * __uint_as_float(y.y & 0xffff0000u);
        acc += __uint_as_float(x.z << 16) * __uint_as_float(y.z << 16); acc += __uint_as_float(x.z & 0xffff0000u) * __uint_as_float(y.z & 0xffff0000u);
        acc += __uint_as_float(x.w << 16) * __uint_as_float(y.w << 16); acc += __uint_as_float(x.w & 0xffff0000u) * __uint_as_float(y.w & 0xffff0000u); }
    return acc; }
DI void naive_gemm_store(Frame& F, const bf16* A, const bf16* Bt, bf16* O, int N, int K) {
    const size_t gt0 = (size_t)F.vcu * (NWAVES * 64) + F.tid, NT = (size_t)F.G * NWAVES * 64;
    for (size_t idx = gt0; idx < (size_t)M * N; idx += NT) { const size_t m = idx / N; const int n = (int)(idx % N);
        O[idx] = (bf16)f2bf(dot_bf16(A + m * K, Bt + (size_t)n * K, K)); }
}
DI void naive_swiglu(Frame& F, const bf16* A, const bf16* Bt, bf16* O) {
    const size_t gt0 = (size_t)F.vcu * (NWAVES * 64) + F.tid, NT = (size_t)F.G * NWAVES * 64;
    for (size_t idx = gt0; idx < (size_t)M * DFF; idx += NT) { const size_t m = idx / DFF; const int n = (int)(idx % DFF);
        const int rg = (n >> 7) * 256 + (n & 127);
        const float g = dot_bf16(A + m * 1024, Bt + (size_t)rg * 1024, 1024), u = dot_bf16(A + m * 1024, Bt + (size_t)(rg + 128) * 1024, 1024);
        O[idx] = (bf16)f2bf(g / (1.0f + expf(-g)) * u); }
}


DI void naive_proj(Frame& F, const bf16* XN, const bf16* Win_t, bf16* BUFW) {
    const size_t gt0 = (size_t)F.vcu * (NWAVES * 64) + F.tid, NT = (size_t)F.G * NWAVES * 64;
    bf16* IKb = (bf16*)(F.ws + WS_IK); float* IWb = (float*)(F.ws + WS_IW); bf16* MKVb = (bf16*)(F.ws + WS_MKV);
    for (size_t idx = gt0; idx < (size_t)M * 7240; idx += NT) { const size_t m = idx / 7240; const int p = (int)(idx % 7240);
        float v = dot_bf16(XN + m * 1024, Win_t + (size_t)p * 1024, 1024);
        if (p < 7168) { const int blk = p >> 9, col = p & 511;
            if (blk >= 8) v = 1.0f / (1.0f + expf(-(v + F.b_gate[(blk - 8) * 512 + col])));
            else v *= (blk == 0 || blk == 4) ? 0.125f * LOG2E : (blk == 3 ? 0.125f : (blk == 7 ? 0.08838834764831845f * LOG2E : 1.0f));
            BUFW[(size_t)blk * BLK + m * 512 + col] = (bf16)f2bf(v); }
        else if (p < 7232) IKb[m * 64 + (p - 7168)] = (bf16)f2bf(v);
        else IWb[m * 8 + (p - 7232)] = v * 0.35355339059327373f; }
    for (size_t idx = gt0; idx < (size_t)1024 * 1024; idx += NT) { const size_t m = idx >> 10; const int n = (int)(idx & 1023);
        MKVb[idx] = (bf16)f2bf(dot_bf16(XN + (M + m) * 1024, Win_t + (size_t)(NIN_PAD + n) * 1024, 1024)); }
}

DI float bfv(bf16 v) { return __uint_as_float((unsigned)v << 16); }
DI void naive_merge(Frame& F, const bf16* BUF, const bf16* Wup_t, bf16* MERGED) {
    const size_t gt0 = (size_t)F.vcu * (NWAVES * 64) + F.tid, NT = (size_t)F.G * NWAVES * 64;
    for (size_t idx = gt0; idx < (size_t)M * 1024; idx += NT) { const size_t m = idx >> 10; const int n = (int)(idx & 1023);
        float tot = 0.f;
        for (int br = 0; br < 3; ++br) { const bf16* a = (const bf16*)F.out + br * BLK + m * 512; const bf16* w = Wup_t + (size_t)(br * 1024 + n) * 512; float acc = 0.f;
            for (int k = 0; k < 512; ++k) acc += bfv(a[k]) * bfv(w[k]);
            const float g = bfv(BUF[(size_t)(8 + 2 * br + (n >> 9)) * BLK + m * 512 + (n & 511)]);
            tot += g * acc; }
        MERGED[idx] = (bf16)f2bf(tot); }
}

struct Args { const float* in[17]; float* out; unsigned char* ws; int ph_lo, ph_hi, li, pad; };
__global__ void __launch_bounds__(NWAVES * 64, 2) mk_fwd(Args args) {
    extern __shared__ __attribute__((aligned(16))) unsigned char lds[];
    Frame F;
    F.lds = (LAS unsigned char*)lds;
    F.MISC = (volatile LAS unsigned*)(F.lds + MISC_OFF);
    F.tid = threadIdx.x; F.lane = F.tid & 63; F.wave = __builtin_amdgcn_readfirstlane(F.tid >> 6);
    F.G = gridDim.x; { const int bx = blockIdx.x; F.vcu = (F.G % 8 == 0) ? (bx % 8) * (F.G / 8) + bx / 8 : bx; }
    F.x = args.in[0];
    F.mem = args.in[1];
    F.rel_bias = args.in[2];
    F.g_mix_pre = args.in[3];
    F.w_in = args.in[4];
    F.b_gate = args.in[5];
    F.g_mem = args.in[6];
    F.w_mem_kv = args.in[7];
    F.w_up_a = args.in[8];
    F.w_up_b = args.in[9];
    F.w_up_c = args.in[10];
    F.w_out = args.in[11];
    F.g_mix_post = args.in[12];
    F.g_ffn_pre = args.in[13];
    F.w_ffn_in = args.in[14];
    F.w_ffn_out = args.in[15];
    F.g_ffn_post = args.in[16];
    F.out = args.out; F.ws = args.ws;
    F.ctl = (gu32*)(args.ws + WS_CTL);
    for (int u = F.tid; u < (LDS_BYTES - LDSCTL_OFF) / 4; u += NWAVES * 64) ((LAS unsigned*)(F.lds + LDSCTL_OFF))[u] = 0u;
    __syncthreads();
    XcdBarrier bar; bar.bar = (unsigned*)(F.ctl + CW_BAR) + args.li * XCD_BAR_WORDS; bar.x = 0; bar.st = nullptr;
    if (N_LAUNCHES != N_PHASES) bar = xcd_barrier_post((unsigned*)(F.ctl + CW_BAR) + args.li * XCD_BAR_WORDS, F.MISC + 8);
#define GRID_BAR() do { if (N_LAUNCHES != N_PHASES) xcd_barrier(bar); } while (0)
    const int lo = args.ph_lo, hi = args.ph_hi;
#ifdef ONLY_PHASE
#define IN(k) ((k) == ONLY_PHASE && lo <= (k) && (k) < hi)
#else
#define IN(k) (lo <= (k) && (k) < hi)
#endif
#define BOTH(k) (IN(k) && IN((k) + 1))
    bf16* BUFW = (bf16*)(args.ws + WS_BUF);
    bf16* XN = (bf16*)args.out;
    bf16* MERGED = BUFW + 1 * BLK;
    bf16* YB = BUFW + 5 * BLK;
    bf16* H2 = BUFW + 1 * BLK;
    bf16* HID = BUFW + 8 * BLK;

#ifndef REP_PHASE
#define REP_PHASE -1
#endif
#define REPS(k) for (int rep_ = 0; rep_ < ((k) == REP_PHASE ? 2 : 1); ++rep_)
    if (IN(0)) REPS(0) { p0_prologue(F); if (BOTH(0) || REP_PHASE == 0) GRID_BAR(); }

    if (IN(1)) REPS(1) {
#ifdef NAIVE_P1
        if (args.pad == 0) naive_proj(F, XN, (const bf16*)(args.ws + WS_WIN), BUFW); else
#endif
        {
        pg8::Gemm g{XN, (const bf16*)(args.ws + WS_WIN), M + MROWS, NIN_PAD + 1024, D}; P1Order S; S.init(F.G, (int)blockIdx.x);
        pg8::EpiProj E{BUFW, BLK, (bf16*)(args.ws + WS_IK), (float*)(args.ws + WS_IW), (bf16*)(args.ws + WS_MKV), F.b_gate,
                       0.125f * LOG2E, 0.125f, 0.08838834764831845f * LOG2E, 0.35355339059327373f, args.pad ? (unsigned*)(F.ctl + 32) : nullptr};
        pg8::gemm_phase<pg8::EpiProj, P1Order, PG8_ALIGN, PG8_SP2>(F.lds + RING_OFF, g, S, E);
        }
        if (BOTH(1) || REP_PHASE == 1) GRID_BAR();
    }

    if (IN(2)) REPS(2) { p2_mixers(F); if (BOTH(2) || REP_PHASE == 2) GRID_BAR(); }

    if (IN(3)) REPS(3) {
#ifdef NAIVE_P3
        naive_merge(F, BUFW, (const bf16*)(args.ws + WS_WUP), MERGED);
#else
        pg8::Gemm g{(const bf16*)args.out, (const bf16*)(args.ws + WS_WUP), M, 1024, 512}; MergeOrder S; S.init(F.G, (int)blockIdx.x);
        pg8::EpiMerge E{BUFW, BLK, MERGED};
        pg8::gemm_phase<pg8::EpiMerge, MergeOrder, PG8_ALIGN, PG8_SP2>(F.lds + RING_OFF, g, S, E);
#endif
        if (BOTH(3) || REP_PHASE == 3) GRID_BAR();
    }

    if (IN(4)) REPS(4) {
#ifdef NAIVE_POST
        naive_gemm_store(F, MERGED, (const bf16*)(args.ws + WS_WOUT), YB, 1024, 1024);
#else
        pg8::Gemm g{MERGED, (const bf16*)(args.ws + WS_WOUT), M, 1024, 1024}; pg8::StaticOrder S; S.init(M, 1024, F.G, (int)blockIdx.x);
        pg8::EpiStore E{YB, 1024};
        pg8::gemm_phase<pg8::EpiStore, pg8::StaticOrder, PG8_ALIGN, PG8_SP2>(F.lds + RING_OFF, g, S, E);
#endif
        if (BOTH(4) || REP_PHASE == 4) GRID_BAR();
    }

    if (IN(5)) REPS(5) { p5_rows(F, YB, H2); if (BOTH(5) || REP_PHASE == 5) GRID_BAR(); }

    if (IN(6)) REPS(6) {
#ifdef NAIVE_POST
        naive_swiglu(F, H2, (const bf16*)(args.ws + WS_WFI), HID);
#else
        pg8::Gemm g{H2, (const bf16*)(args.ws + WS_WFI), M, 2 * DFF, 1024}; pg8::StaticOrder S; S.init(M, 2 * DFF, F.G, (int)blockIdx.x);
        pg8::EpiSwiGLU E{HID, DFF};
        pg8::gemm_phase<pg8::EpiSwiGLU, pg8::StaticOrder, PG8_ALIGN, PG8_SP2>(F.lds + RING_OFF, g, S, E);
#endif
        if (BOTH(6) || REP_PHASE == 6) GRID_BAR();
    }

    if (IN(7)) REPS(7) {
#ifdef NAIVE_POST
        naive_gemm_store(F, HID, (const bf16*)(args.ws + WS_WFO), YB, 1024, DFF);
#else
        pg8::Gemm g{HID, (const bf16*)(args.ws + WS_WFO), M, 1024, DFF}; pg8::StaticOrder S; S.init(M, 1024, F.G, (int)blockIdx.x);
        pg8::EpiStore E{YB, 1024};
        pg8::gemm_phase<pg8::EpiStore, pg8::StaticOrder, PG8_ALIGN, PG8_SP2>(F.lds + RING_OFF, g, S, E);
#endif
        if (BOTH(7) || REP_PHASE == 7) GRID_BAR();
    }

    if (IN(8)) { p8_rows(F, YB); }
#undef IN
#undef BOTH
}

extern "C" void kernel_launch(void* const* d_in, const int* in_sizes, int n_in, void* d_out, int out_size, void* d_ws, size_t ws_size, hipStream_t stream) {
    static int grid = 0;
    if (grid == 0) {
        if (n_in != 17 || in_sizes[0] != M * D || out_size != M * D || ws_size < WS_END) { fprintf(stderr, "kernel_launch: unexpected shapes / workspace (n_in %d, ws %zu); nothing launched\n", n_in, ws_size); grid = -1; return; }
        int dev = 0, cus = 0, per_cu = 0;
        if (hipGetDevice(&dev) != hipSuccess || hipDeviceGetAttribute(&cus, hipDeviceAttributeMultiprocessorCount, dev) != hipSuccess) { grid = -1; return; }
        if (hipFuncSetAttribute((const void*)mk_fwd, hipFuncAttributeMaxDynamicSharedMemorySize, LDS_BYTES) != hipSuccess) { fprintf(stderr, "kernel_launch: hipFuncSetAttribute failed\n"); grid = -1; return; }
        if (hipOccupancyMaxActiveBlocksPerMultiprocessor(&per_cu, (const void*)mk_fwd, NWAVES * 64, LDS_BYTES) != hipSuccess || per_cu < 1)
            fprintf(stderr, "kernel_launch: note: occupancy query reports %d workgroups per CU\n", per_cu);
        (void)hipGetLastError();
        grid = cus;
    }
    if (grid < 0) return;
    if (hipMemsetAsync((char*)d_ws + WS_CTL, 0, CTL_ZERO_BYTES, stream) != hipSuccess) return;
    Args a{};
    for (int i = 0; i < 17; ++i) a.in[i] = (const float*)d_in[i];
    a.out = (float*)d_out; a.ws = (unsigned char*)d_ws; a.pad = 0;
#ifndef RUN_LO
#define RUN_LO 0
#endif
#ifndef RUN_HI
#define RUN_HI N_PHASES
#endif
    for (int li = 0; li < N_LAUNCHES; ++li) {
        if (N_LAUNCHES == N_PHASES && (li < RUN_LO || li >= RUN_HI)) continue;
        a.ph_lo = (N_LAUNCHES == N_PHASES) ? li : 0; a.ph_hi = (N_LAUNCHES == N_PHASES) ? li + 1 : N_PHASES; a.li = (N_LAUNCHES == N_PHASES) ? 0 : li;
        hipLaunchKernelGGL(mk_fwd, dim3(grid), dim3(NWAVES * 64), LDS_BYTES, stream, a);
#ifdef CMP_P1
        if (N_LAUNCHES == N_PHASES && li == 1) { a.pad = 1; hipLaunchKernelGGL(mk_fwd, dim3(grid), dim3(NWAVES * 64), LDS_BYTES, stream, a); a.pad = 0; }
#endif
    }
}
```
